# Optimizing an MI355X kernel written in HIP

```python
import math
import jax, jax.numpy as jnp
from jax import lax
import numpy as np

D_MODEL = 1024
BATCH = 32
SEQ = 256
DEPTH = 4
DEC_BATCH = 8
DEC_SEQ = 1024
PAST_LEN = 512

GRID_W = 64
CHUNK = 128
A_HEADS = 4
A_DH = 32
A_DV = 64
B_WIDTH = 256
B_GROUPS = 4
C_HEADS = 4
C_DK = 64
C_DV = 64
D_WIDTH = 256
CONV_W = 31
MIX_WIDTH = A_HEADS * A_DV + B_WIDTH + C_HEADS * C_DV + D_WIDTH
IN_SPLITS = (A_HEADS * 2 * A_DH, A_HEADS * 2 * A_DH, A_HEADS * A_DV,
             B_WIDTH, B_WIDTH,
             C_HEADS * C_DK, C_HEADS * C_DK, C_HEADS * C_DV, C_HEADS * C_DV,
             D_WIDTH, D_WIDTH)
IN_WIDTH = sum(IN_SPLITS)
PEER_HEADS = 8
PEER_DQ = 128
N_KEYS = 128
N_EXPERTS = N_KEYS * N_KEYS
PEER_TOPK = 16
PEER_BLOCK = 128
ROPE_BASE = 10000.0
LN_EPS = 1e-5
DEEPNORM_ALPHA = (2 * DEPTH) ** 0.25
DEEPNORM_BETA = (8 * DEPTH) ** -0.25
F32 = jnp.float32

kernel_name = 'hybrid_diffusion_step'


def layer_norm(x, g=None, b=None):
    xf = x.astype(F32)
    mu = xf.mean(-1, keepdims=True)
    var = jnp.square(xf - mu).mean(-1, keepdims=True)
    y = (xf - mu) * lax.rsqrt(var + LN_EPS)
    if g is not None:
        y = y * g.astype(F32) + b.astype(F32)
    return y.astype(x.dtype)


def rms_norm(x, g):
    xf = x.astype(F32)
    y = xf * lax.rsqrt(jnp.mean(xf * xf, -1, keepdims=True) + LN_EPS) * g.astype(F32)
    return y.astype(x.dtype)


def split_cols(z):
    parts, start = [], 0
    for w in IN_SPLITS:
        parts.append(z[..., start:start + w])
        start += w
    return parts


def grid_positions(n):
    rows = n // GRID_W
    r = jnp.broadcast_to(jnp.arange(rows)[:, None], (rows, GRID_W)).reshape(-1)
    c = jnp.broadcast_to(jnp.arange(GRID_W)[None, :], (rows, GRID_W)).reshape(-1)
    return r, c


def rope_1d(x, pos):
    half = x.shape[-1] // 2
    inv = ROPE_BASE ** (-jnp.arange(half, dtype=F32) / half)
    ang = pos.astype(F32)[:, None] * inv[None, :]
    cos = jnp.cos(ang)[None, :, None, None, :]
    sin = jnp.sin(ang)[None, :, None, None, :]
    xf = x.astype(F32)
    x1, x2 = xf[..., :half], xf[..., half:]
    return jnp.concatenate([x1 * cos - x2 * sin, x2 * cos + x1 * sin], -1).astype(x.dtype)


def axial_rope(x, rows, cols):
    b, n, h, _ = x.shape
    xs = x.reshape(b, n, h, 2, A_DH)
    q = A_DH // 2
    out = jnp.concatenate([rope_1d(xs[..., :q], rows), rope_1d(xs[..., q:], cols)], -1)
    return out.reshape(b, n, h, 2 * A_DH)


def lambda_init(l):
    return 0.8 - 0.6 * math.exp(-0.3 * l)


def diff_attention(q, k, v, lam):
    b, nq, h, _ = q.shape
    qb = q.reshape(b, nq // CHUNK, CHUNK, h, 2 * A_DH).transpose(1, 0, 2, 3, 4)
    kf = k.astype(F32)
    vf = v.astype(F32)
    k1, k2 = kf[..., :A_DH], kf[..., A_DH:]
    scale = A_DH ** -0.5

    def block(qblk):
        qf = qblk.astype(F32) * scale
        a1 = jax.nn.softmax(jnp.einsum('bqhd,bkhd->bhqk', qf[..., :A_DH], k1), axis=-1)
        a2 = jax.nn.softmax(jnp.einsum('bqhd,bkhd->bhqk', qf[..., A_DH:], k2), axis=-1)
        return jnp.einsum('bhqk,bkhd->bqhd', a1 - lam * a2, vf)

    o = lax.map(block, qb)
    return o.transpose(1, 0, 2, 3, 4).reshape(b, nq, h, A_DV)


def mixer_diff_attn(qa, ka, va, lam_p, subln_g, l, ctx_kv, pos):
    b, n, _ = qa.shape
    q = qa.reshape(b, n, A_HEADS, 2 * A_DH)
    k = ka.reshape(b, n, A_HEADS, 2 * A_DH)
    v = va.reshape(b, n, A_HEADS, A_DV)
    if ctx_kv is None:
        keys, vals = k, v
    else:
        q = axial_rope(q, pos[0], pos[1])
        keys = jnp.concatenate([ctx_kv[0].astype(k.dtype), axial_rope(k, pos[0], pos[1])], axis=1)
        vals = jnp.concatenate([ctx_kv[1].astype(v.dtype), v], axis=1)
    lp = lam_p.astype(F32)
    lam_i = lambda_init(l)
    lam = jnp.exp(jnp.sum(lp[0] * lp[1])) - jnp.exp(jnp.sum(lp[2] * lp[3])) + lam_i
    o = diff_attention(q, keys, vals, lam)
    o = rms_norm(o, subln_g) * (1.0 - lam_i)
    return o.reshape(b, n, A_HEADS * A_DV).astype(qa.dtype), (k, v)


def mixer_gmlp(ub, vb, ws, bs, ln_g, ln_b):
    b, n, _ = ub.shape
    u = jax.nn.gelu(ub)
    v = layer_norm(jax.nn.gelu(vb), ln_g, ln_b)
    vc = v.reshape(b, n // CHUNK, CHUNK, B_GROUPS, B_WIDTH // B_GROUPS)
    mixed = jnp.einsum('gpq,bcqgd->bcpgd', ws, vc) + bs.T[None, None, :, :, None]
    return u * mixed.reshape(b, n, B_WIDTH)


def retention_scan(q, k, v, log_gamma, s0):
    b, n, h, _ = q.shape
    nc = n // CHUNK

    def chunks(t):
        return t.reshape(b, nc, CHUNK, h, t.shape[-1]).transpose(1, 0, 3, 2, 4)

    pos = jnp.arange(CHUNK, dtype=F32)
    rel = pos[:, None] - pos[None, :]
    decay_mask = jnp.where(rel >= 0, jnp.exp(log_gamma[:, None, None] * jnp.maximum(rel, 0.0)), 0.0)
    q_decay = jnp.exp(log_gamma[:, None] * (pos + 1.0))[None, :, :, None]
    k_decay = jnp.exp(log_gamma[:, None] * (CHUNK - 1.0 - pos))[None, :, :, None]
    chunk_decay = jnp.exp(log_gamma * CHUNK)[None, :, None, None]

    def step(state, inp):
        qc, kc, vc = inp
        scores = jnp.einsum('bhtd,bhsd->bhts', qc, kc) * decay_mask
        out = (jnp.einsum('bhts,bhsv->bhtv', scores, vc)
               + jnp.einsum('bhtd,bhdv->bhtv', qc * q_decay, state))
        state = state * chunk_decay + jnp.einsum('bhsd,bhsv->bhdv', kc * k_decay, vc)
        return state, out

    s_final, out = lax.scan(step, s0.astype(F32), (chunks(q), chunks(k), chunks(v)))
    out = out.transpose(1, 0, 3, 2, 4).reshape(b, n, h, v.shape[-1])
    return out, s_final


def mixer_retention(qc, kc, vc, gc, decay_logit, s0_f, s0_b):
    b, n, _ = qc.shape
    q = qc.reshape(b, n, C_HEADS, C_DK).astype(F32)
    k = kc.reshape(b, n, C_HEADS, C_DK).astype(F32) * (C_DK ** -0.5)
    v = vc.reshape(b, n, C_HEADS, C_DV).astype(F32)
    lg = jax.nn.log_sigmoid(decay_logit.astype(F32))
    o_f, s_f = retention_scan(q, k, v, lg[0], s0_f)
    o_b, s_b = retention_scan(q[:, ::-1], k[:, ::-1], v[:, ::-1], lg[1], s0_b)
    o = layer_norm(o_f + o_b[:, ::-1])
    o = o.reshape(b, n, C_HEADS * C_DV) * jax.nn.silu(gc.astype(F32))
    return o.astype(qc.dtype), (s_f, s_b)


def mixer_conv(ad, bd, w, bias, ln_g, ln_b):
    h = ad * jax.nn.sigmoid(bd)
    y = lax.conv_general_dilated(h, w[:, None, :].astype(h.dtype), (1,),
                                 [(CONV_W // 2, CONV_W // 2)],
                                 dimension_numbers=('NWC', 'WIO', 'NWC'),
                                 feature_group_count=D_WIDTH)
    y = layer_norm(y + bias.astype(y.dtype), ln_g, ln_b)
    return jax.nn.silu(y)


def peer(h, wq, keys, U, V):
    b, n, d = h.shape
    T = b * n
    x = h.reshape(T, d)
    q = (x @ wq).reshape(T, PEER_HEADS, 2, PEER_DQ // 2).astype(F32)
    s = jnp.einsum('thpd,pkd->thpk', q, keys.astype(F32))
    s1, i1 = lax.top_k(s[:, :, 0], PEER_TOPK)
    s2, i2 = lax.top_k(s[:, :, 1], PEER_TOPK)
    cand = (s1[..., :, None] + s2[..., None, :]).reshape(T, PEER_HEADS, PEER_TOPK * PEER_TOPK)
    cidx = (i1[..., :, None] * N_KEYS + i2[..., None, :]).reshape(T, PEER_HEADS, PEER_TOPK * PEER_TOPK)
    top_s, top_j = lax.top_k(cand, PEER_TOPK)
    eidx = jnp.take_along_axis(cidx, top_j, axis=-1)
    gate = jax.nn.softmax(top_s, axis=-1)
    E = PEER_HEADS * PEER_TOPK
    nb = T // PEER_BLOCK
    xb = x.reshape(nb, PEER_BLOCK, d)
    ib = eidx.reshape(nb, PEER_BLOCK, E)
    gb = gate.reshape(nb, PEER_BLOCK, E)

    def block(args):
        xt, it, gt = args
        u = jnp.take(U, it, axis=0)
        act = jax.nn.gelu(jnp.einsum('td,ted->te', xt, u).astype(F32))
        v = jnp.take(V, it, axis=0)
        return jnp.einsum('te,ted->td', (gt * act).astype(v.dtype), v)

    y = lax.map(block, (xb, ib, gb))
    return y.reshape(b, n, d).astype(h.dtype)


def trunk_layer(x, cvec, p, l, ctx=None):
    b, n, _ = x.shape
    mod = jax.nn.silu(cvec) @ p['w_mod'] + p['b_mod']
    sh1, sc1, g1, sh2, sc2, g2 = [m[:, None, :] for m in jnp.split(mod, 6, axis=-1)]
    h = x * (1.0 + sc1) + sh1
    z = h @ p['w_in']
    qa, ka, va, ub, vb, qc, kc, vc, gc, ad, bd = split_cols(z)
    is_ctx = ctx is None
    if is_ctx:
        oa, kv = mixer_diff_attn(qa, ka, va, p['diff_lambda'], p['diff_subln_g'], l, None, None)
        s0_f = jnp.zeros((b, C_HEADS, C_DK, C_DV), F32)
        s0_b = s0_f
    else:
        oa, kv = mixer_diff_attn(qa, ka, va, p['diff_lambda'], p['diff_subln_g'], l,
                                 (ctx[0], ctx[1]), grid_positions(n))
        s0_f, s0_b = ctx[2], ctx[3]
    ob = mixer_gmlp(ub, vb, p['gmlp_ws'], p['gmlp_bs'], p['gmlp_ln_g'], p['gmlp_ln_b'])
    oc, (s_f, s_b) = mixer_retention(qc, kc, vc, gc, p['ret_decay'], s0_f, s0_b)
    od = mixer_conv(ad, bd, p['conv_w'], p['conv_b'], p['conv_ln_g'], p['conv_ln_b'])
    mix = jnp.concatenate([oa, ob, oc, od], axis=-1) @ p['w_out']
    x = layer_norm(DEEPNORM_ALPHA * x + g1 * mix, p['ln1_g'], p['ln1_b'])
    h = x * (1.0 + sc2) + sh2
    f = peer(h, p['peer_wq'], p['peer_keys'], p['peer_u'], p['peer_v'])
    x = layer_norm(DEEPNORM_ALPHA * x + g2 * f, p['ln2_g'], p['ln2_b'])
    if is_ctx:
        return x, (kv[0], kv[1], s_f, s_b)
    return x, None


def setup_inputs(seed: int = 0) -> dict:
    key = jax.random.key(seed)
    ks = jax.random.split(key, 30)

    def nrm(k, shape, s):
        return jax.random.normal(k, shape, F32) * s

    gam = 1.0 - 2.0 ** (-5.0 - np.arange(C_HEADS))
    decay_logit = jnp.asarray(np.log(gam / (1.0 - gam)).astype(np.float32))
    return {
        'x_prompt': nrm(ks[0], (BATCH, SEQ, D_MODEL), 1.0),
        'x_sample': nrm(ks[1], (DEC_BATCH, DEC_SEQ, D_MODEL), 1.0),
        'cache_k': nrm(ks[2], (DEC_BATCH, DEPTH, PAST_LEN, A_HEADS, 2 * A_DH), 1.0),
        'cache_v': nrm(ks[3], (DEC_BATCH, DEPTH, PAST_LEN, A_HEADS, A_DV), 1.0),
        'state_ret': nrm(ks[4], (DEC_BATCH, DEPTH, 2, C_HEADS, C_DK, C_DV), 1.0),
        'c': nrm(ks[5], (DEC_BATCH, D_MODEL), 1.0),
        'c_ctx': nrm(ks[6], (D_MODEL,), 1.0),
        'w_mod': nrm(ks[7], (DEPTH, D_MODEL, 6 * D_MODEL), 0.5 * D_MODEL ** -0.5),
        'b_mod': nrm(ks[8], (DEPTH, 6 * D_MODEL), 0.01),
        'w_in': nrm(ks[9], (DEPTH, D_MODEL, IN_WIDTH), D_MODEL ** -0.5),
        'diff_lambda': nrm(ks[10], (DEPTH, 4, A_DH), 0.1),
        'diff_subln_g': 1.0 + nrm(ks[11], (DEPTH, A_DV), 0.01),
        'gmlp_ln_g': 1.0 + nrm(ks[12], (DEPTH, B_WIDTH), 0.01),
        'gmlp_ln_b': nrm(ks[13], (DEPTH, B_WIDTH), 0.01),
        'gmlp_ws': nrm(ks[14], (DEPTH, B_GROUPS, CHUNK, CHUNK), 0.5 * CHUNK ** -0.5),
        'gmlp_bs': 1.0 + nrm(ks[15], (DEPTH, B_GROUPS, CHUNK), 0.01),
        'ret_decay': decay_logit[None, None, :] + nrm(ks[16], (DEPTH, 2, C_HEADS), 0.01),
        'conv_w': nrm(ks[17], (DEPTH, CONV_W, D_WIDTH), CONV_W ** -0.5),
        'conv_b': nrm(ks[18], (DEPTH, D_WIDTH), 0.01),
        'conv_ln_g': 1.0 + nrm(ks[19], (DEPTH, D_WIDTH), 0.01),
        'conv_ln_b': nrm(ks[20], (DEPTH, D_WIDTH), 0.01),
        'w_out': nrm(ks[21], (DEPTH, MIX_WIDTH, D_MODEL), DEEPNORM_BETA * MIX_WIDTH ** -0.5),
        'ln1_g': 1.0 + nrm(ks[22], (DEPTH, D_MODEL), 0.01),
        'ln1_b': nrm(ks[23], (DEPTH, D_MODEL), 0.01),
        'ln2_g': 1.0 + nrm(ks[24], (DEPTH, D_MODEL), 0.01),
        'ln2_b': nrm(ks[25], (DEPTH, D_MODEL), 0.01),
        'peer_wq': nrm(ks[26], (DEPTH, D_MODEL, PEER_HEADS * PEER_DQ), D_MODEL ** -0.5),
        'peer_keys': nrm(ks[27], (DEPTH, 2, N_KEYS, PEER_DQ // 2), (PEER_DQ // 2) ** -0.5),
        'peer_u': nrm(ks[28], (DEPTH, N_EXPERTS, D_MODEL), D_MODEL ** -0.5),
        'peer_v': nrm(ks[29], (DEPTH, N_EXPERTS, D_MODEL), DEEPNORM_BETA * PEER_HEADS ** -0.5),
    }


def reference(x_prompt, x_sample, cache_k, cache_v, state_ret, c, c_ctx,
              w_mod, b_mod, w_in, diff_lambda, diff_subln_g,
              gmlp_ln_g, gmlp_ln_b, gmlp_ws, gmlp_bs, ret_decay,
              conv_w, conv_b, conv_ln_g, conv_ln_b, w_out,
              ln1_g, ln1_b, ln2_g, ln2_b,
              peer_wq, peer_keys, peer_u, peer_v):
    ctx_cond = c_ctx[None, :]
    xp, xs = x_prompt, x_sample
    ks_out, vs_out, ss_out = [], [], []
    for l in range(DEPTH):
        p = {
            'w_mod': w_mod[l], 'b_mod': b_mod[l], 'w_in': w_in[l],
            'diff_lambda': diff_lambda[l], 'diff_subln_g': diff_subln_g[l],
            'gmlp_ln_g': gmlp_ln_g[l], 'gmlp_ln_b': gmlp_ln_b[l],
            'gmlp_ws': gmlp_ws[l], 'gmlp_bs': gmlp_bs[l], 'ret_decay': ret_decay[l],
            'conv_w': conv_w[l], 'conv_b': conv_b[l],
            'conv_ln_g': conv_ln_g[l], 'conv_ln_b': conv_ln_b[l], 'w_out': w_out[l],
            'ln1_g': ln1_g[l], 'ln1_b': ln1_b[l], 'ln2_g': ln2_g[l], 'ln2_b': ln2_b[l],
            'peer_wq': peer_wq[l], 'peer_keys': peer_keys[l],
            'peer_u': peer_u[l], 'peer_v': peer_v[l],
        }
        xp, (k_l, v_l, sf_l, sb_l) = trunk_layer(xp, ctx_cond, p, l)
        ks_out.append(k_l)
        vs_out.append(v_l)
        ss_out.append(jnp.stack([sf_l, sb_l], axis=1))
        xs, _ = trunk_layer(xs, c, p, l,
                            (cache_k[:, l], cache_v[:, l], state_ret[:, l, 0], state_ret[:, l, 1]))
    new_k = jnp.stack(ks_out, axis=1)
    new_v = jnp.stack(vs_out, axis=1)
    new_state_ret = jnp.stack(ss_out, axis=1)
    return (xp, xs, new_k, new_v, new_state_ret)
```

```cpp
#include <hip/hip_runtime.h>
#include <stdint.h>

constexpr int D = 1024;
constexpr int T = 16384;
constexpr int TCTX = 8192;
constexpr int INW = 2816;
constexpr int DEPTH = 4;
constexpr int NCOND = 9;
constexpr float LN_EPS = 1e-5f;
constexpr float ALPHA = 1.681792830507429f;

constexpr int C_QA = 0, C_KA = 256, C_VA = 512, C_UB = 768, C_VB = 1024, C_QC = 1280, C_KC = 1536,
              C_VC = 1792, C_GC = 2048, C_AD = 2304, C_BD = 2560;

constexpr size_t O_YP = 0, O_YS = 8388608, O_NK = 16777216, O_NV = 25165824, O_NS = 33554432;

struct In {
  const float *x_prompt, *x_sample, *cache_k, *cache_v, *state_ret, *c, *c_ctx, *w_mod, *b_mod, *w_in,
      *diff_lambda, *diff_subln_g, *gmlp_ln_g, *gmlp_ln_b, *gmlp_ws, *gmlp_bs, *ret_decay, *conv_w, *conv_b,
      *conv_ln_g, *conv_ln_b, *w_out, *ln1_g, *ln1_b, *ln2_g, *ln2_b, *peer_wq, *peer_keys, *peer_u, *peer_v;
};

__device__ __forceinline__ float sigmoid_f(float x) { return 1.f / (1.f + expf(-x)); }
__device__ __forceinline__ float silu_f(float x) { return x * sigmoid_f(x); }
__device__ __forceinline__ float gelu_f(float x) {
  float u = 0.7978845608028654f * (x + 0.044715f * x * x * x);
  return x * sigmoid_f(2.f * u);
}
__device__ __forceinline__ int cond_of(int t) { return t < TCTX ? 0 : 1 + ((t - TCTX) >> 10); }
__device__ __forceinline__ float lam_init(int l) { return 0.8f - 0.6f * expf(-0.3f * (float)l); }

__device__ __forceinline__ float wave_sum(float v) {
#pragma unroll
  for (int o = 32; o > 0; o >>= 1) v += __shfl_xor(v, o);
  return v;
}
__device__ __forceinline__ float block_sum256(float v, float* red) {
  v = wave_sum(v);
  __syncthreads();
  if ((threadIdx.x & 63) == 0) red[threadIdx.x >> 6] = v;
  __syncthreads();
  return red[0] + red[1] + red[2] + red[3];
}

__global__ void mod_kernel(In in, float* mod) {
  int idx = blockIdx.x * 256 + threadIdx.x;
  if (idx >= DEPTH * NCOND * 6144) return;
  int n = idx % 6144;
  int c = (idx / 6144) % NCOND;
  int l = idx / (6144 * NCOND);
  const float* cv = c == 0 ? in.c_ctx : in.c + (size_t)(c - 1) * D;
  const float* w = in.w_mod + (size_t)l * D * 6144 + n;
  float acc = in.b_mod[l * 6144 + n];
  for (int k = 0; k < D; ++k) acc += silu_f(cv[k]) * w[(size_t)k * 6144];
  mod[idx] = acc;
}

__global__ void rope_table_kernel(float2* tab) {
  int idx = threadIdx.x;
  int pos = idx >> 3, i = idx & 7;
  float inv = powf(10000.f, -(float)i / 8.f);
  float angf = (float)pos * inv;
  double x = (double)angf;
  double kq = rint(x * 0.6366197723675814);
  double r = x - kq * 1.5707963267948966;
  double r2 = r * r;
  double s = r * (1.0 + r2 * (-1.0 / 6 + r2 * (1.0 / 120 + r2 * (-1.0 / 5040 + r2 * (1.0 / 362880 + r2 * (-1.0 / 39916800 + r2 * (1.0 / 6227020800.0)))))));
  double c = 1.0 + r2 * (-0.5 + r2 * (1.0 / 24 + r2 * (-1.0 / 720 + r2 * (1.0 / 40320 + r2 * (-1.0 / 3628800 + r2 * (1.0 / 479001600.0 + r2 * (-1.0 / 87178291200.0)))))));
  int q = ((int)kq) & 3;
  double cs, sn;
  if (q == 0) { cs = c; sn = s; }
  else if (q == 1) { cs = -s; sn = c; }
  else if (q == 2) { cs = -c; sn = -s; }
  else { cs = s; sn = -c; }
  tab[idx] = make_float2((float)cs, (float)sn);
}

__global__ void modulate_kernel(const float* X, const float* mod_l, float* H) {
  size_t idx = (size_t)blockIdx.x * 256 + threadIdx.x;
  int t = (int)(idx >> 10), d = (int)(idx & 1023);
  const float* m = mod_l + (size_t)cond_of(t) * 6144;
  H[idx] = X[idx] * (1.f + m[1024 + d]) + m[d];
}

__global__ void __launch_bounds__(256) sgemm_kernel(const float* __restrict__ A, const float* __restrict__ B,
                                                    float* __restrict__ C, int M, int N, int K) {
  __shared__ float As[16][68];
  __shared__ float Bs[16][68];
  const int tid = threadIdx.x;
  const int tx = tid & 15, ty = tid >> 4;
  const int bm = blockIdx.y * 64, bn = blockIdx.x * 64;
  float acc[4][4];
#pragma unroll
  for (int i = 0; i < 4; ++i)
#pragma unroll
    for (int j = 0; j < 4; ++j) acc[i][j] = 0.f;
  for (int k0 = 0; k0 < K; k0 += 16) {
    float4 a = *(const float4*)&A[(size_t)(bm + (tid >> 2)) * K + k0 + (tid & 3) * 4];
    float4 b = *(const float4*)&B[(size_t)(k0 + (tid >> 4)) * N + bn + (tid & 15) * 4];
    As[(tid & 3) * 4 + 0][tid >> 2] = a.x;
    As[(tid & 3) * 4 + 1][tid >> 2] = a.y;
    As[(tid & 3) * 4 + 2][tid >> 2] = a.z;
    As[(tid & 3) * 4 + 3][tid >> 2] = a.w;
    *(float4*)&Bs[tid >> 4][(tid & 15) * 4] = b;
    __syncthreads();
#pragma unroll
    for (int kk = 0; kk < 16; ++kk) {
      float4 av = *(const float4*)&As[kk][ty * 4];
      float4 bv = *(const float4*)&Bs[kk][tx * 4];
      float aa[4] = {av.x, av.y, av.z, av.w};
      float bb[4] = {bv.x, bv.y, bv.z, bv.w};
#pragma unroll
      for (int i = 0; i < 4; ++i)
#pragma unroll
        for (int j = 0; j < 4; ++j) acc[i][j] += aa[i] * bb[j];
    }
    __syncthreads();
  }
#pragma unroll
  for (int i = 0; i < 4; ++i) {
    float4 o = make_float4(acc[i][0], acc[i][1], acc[i][2], acc[i][3]);
    *(float4*)&C[(size_t)(bm + ty * 4 + i) * N + bn + tx * 4] = o;
  }
}

__global__ void kv_out_kernel(const float* Z, float* out, int l) {
  int idx = blockIdx.x * 256 + threadIdx.x;
  int t = idx >> 8, cidx = idx & 255;
  int b = t >> 8, n = t & 255;
  size_t o = ((size_t)(b * DEPTH + l) * 256 + n) * 256 + cidx;
  out[O_NK + o] = Z[(size_t)t * INW + C_KA + cidx];
  out[O_NV + o] = Z[(size_t)t * INW + C_VA + cidx];
}

__global__ void rope_qk_kernel(const float* Z, const float2* tab, float* QR, float* KR) {
  int idx = blockIdx.x * 256 + threadIdx.x;
  int tl = idx >> 8, cidx = idx & 255;
  int n = tl & 1023;
  int row = n >> 6, col = n & 63;
  int d = cidx & 63;
  int sub = d & 15, i = sub & 7;
  bool first = sub < 8;
  bool usecol = (d & 31) >= 16;
  int pos = usecol ? col : row;
  float2 cs = tab[pos * 8 + i];
  const float* zr = Z + (size_t)(TCTX + tl) * INW;
  int pc = first ? cidx + 8 : cidx - 8;
  float xq = zr[C_QA + cidx], xqp = zr[C_QA + pc];
  float xk = zr[C_KA + cidx], xkp = zr[C_KA + pc];
  float oq = first ? xq * cs.x - xqp * cs.y : xq * cs.x + xqp * cs.y;
  float ok = first ? xk * cs.x - xkp * cs.y : xk * cs.x + xkp * cs.y;
  QR[idx] = oq;
  KR[idx] = ok;
}

__global__ void __launch_bounds__(64) attn_naive_kernel(In in, const float* Z, const float* QR, const float* KR,
                                                        float* MIXCAT, int l) {
  int blk = blockIdx.x;
  bool lat = blk >= 512;
  int seq, h, qb;
  if (!lat) { seq = blk / 16; h = (blk / 4) & 3; qb = blk & 3; }
  else { int r = blk - 512; seq = r / 64; h = (r / 16) & 3; qb = r & 15; }
  int n = qb * 64 + threadIdx.x;
  int tbase = lat ? TCTX + seq * 1024 : seq * 256;
  int t = tbase + n;
  int nkeys = lat ? 1536 : 256;
  const float scale = 0.17677669529663687f;
  float q[64];
#pragma unroll
  for (int d = 0; d < 64; ++d)
    q[d] = (lat ? QR[(size_t)(t - TCTX) * 256 + h * 64 + d] : Z[(size_t)t * INW + C_QA + h * 64 + d]) * scale;
  const float* lp = in.diff_lambda + l * 128;
  float s01 = 0.f, s23 = 0.f;
  for (int i = 0; i < 32; ++i) { s01 += lp[i] * lp[32 + i]; s23 += lp[64 + i] * lp[96 + i]; }
  float li = lam_init(l);
  float lam = expf(s01) - expf(s23) + li;

  float m1 = -1e30f, m2 = -1e30f, l1 = 0.f, l2 = 0.f;
  for (int j = 0; j < nkeys; ++j) {
    const float* kp;
    if (!lat) kp = Z + (size_t)(tbase + j) * INW + C_KA + h * 64;
    else if (j < 512) kp = in.cache_k + ((size_t)((seq * DEPTH + l) * 512 + j) * 4 + h) * 64;
    else kp = KR + (size_t)(seq * 1024 + j - 512) * 256 + h * 64;
    float s1 = 0.f, s2 = 0.f;
#pragma unroll
    for (int d = 0; d < 32; ++d) { s1 += q[d] * kp[d]; s2 += q[32 + d] * kp[32 + d]; }
    float nm1 = fmaxf(m1, s1); l1 = l1 * expf(m1 - nm1) + expf(s1 - nm1); m1 = nm1;
    float nm2 = fmaxf(m2, s2); l2 = l2 * expf(m2 - nm2) + expf(s2 - nm2); m2 = nm2;
  }
  float il1 = 1.f / l1, il2 = 1.f / l2;
  float o[64];
#pragma unroll
  for (int d = 0; d < 64; ++d) o[d] = 0.f;
  for (int j = 0; j < nkeys; ++j) {
    const float *kp, *vp;
    if (!lat) { kp = Z + (size_t)(tbase + j) * INW + C_KA + h * 64; vp = Z + (size_t)(tbase + j) * INW + C_VA + h * 64; }
    else if (j < 512) {
      kp = in.cache_k + ((size_t)((seq * DEPTH + l) * 512 + j) * 4 + h) * 64;
      vp = in.cache_v + ((size_t)((seq * DEPTH + l) * 512 + j) * 4 + h) * 64;
    } else {
      kp = KR + (size_t)(seq * 1024 + j - 512) * 256 + h * 64;
      vp = Z + (size_t)(tbase + j - 512) * INW + C_VA + h * 64;
    }
    float s1 = 0.f, s2 = 0.f;
#pragma unroll
    for (int d = 0; d < 32; ++d) { s1 += q[d] * kp[d]; s2 += q[32 + d] * kp[32 + d]; }
    float w = expf(s1 - m1) * il1 - lam * expf(s2 - m2) * il2;
#pragma unroll
    for (int d = 0; d < 64; ++d) o[d] += w * vp[d];
  }
  float ss = 0.f;
#pragma unroll
  for (int d = 0; d < 64; ++d) ss += o[d] * o[d];
  float r = rsqrtf(ss * (1.f / 64.f) + LN_EPS) * (1.f - li);
  const float* g = in.diff_subln_g + l * 64;
#pragma unroll
  for (int d = 0; d < 64; ++d) MIXCAT[(size_t)t * D + h * 64 + d] = o[d] * r * g[d];
}

__global__ void __launch_bounds__(256) gmlp_ln_kernel(In in, const float* Z, float* GV, int l) {
  __shared__ float red[4];
  int t = blockIdx.x, ch = threadIdx.x;
  float v = gelu_f(Z[(size_t)t * INW + C_VB + ch]);
  float mu = block_sum256(v, red) * (1.f / 256.f);
  float dv = v - mu;
  float var = block_sum256(dv * dv, red) * (1.f / 256.f);
  GV[(size_t)t * 256 + ch] = dv * rsqrtf(var + LN_EPS) * in.gmlp_ln_g[l * 256 + ch] + in.gmlp_ln_b[l * 256 + ch];
}
__global__ void __launch_bounds__(256) gmlp_mix_kernel(In in, const float* Z, const float* GV, float* MIXCAT, int l) {
  int t = blockIdx.x, ch = threadIdx.x;
  int g = ch >> 6, p = t & 127, base = t - p;
  const float* ws = in.gmlp_ws + ((size_t)(l * 4 + g) * 128 + p) * 128;
  float acc = 0.f;
  for (int q = 0; q < 128; ++q) acc += ws[q] * GV[(size_t)(base + q) * 256 + ch];
  acc += in.gmlp_bs[(l * 4 + g) * 128 + p];
  MIXCAT[(size_t)t * D + 256 + ch] = gelu_f(Z[(size_t)t * INW + C_UB + ch]) * acc;
}

__global__ void __launch_bounds__(64) ret_scan_kernel(In in, const float* Z, float* OFB, float* out, int l) {
  int blk = blockIdx.x;
  int dir = blk & 1, h = (blk >> 1) & 3, seq = blk >> 3;
  bool lat = seq >= 32;
  int n = lat ? 1024 : 256;
  int tbase = lat ? TCTX + (seq - 32) * 1024 : seq * 256;
  int j = threadIdx.x;
  float logit = in.ret_decay[(l * 2 + dir) * 4 + h];
  float gamma = sigmoid_f(logit);
  float S[64];
  if (lat) {
    const float* s0 = in.state_ret + ((size_t)(((seq - 32) * DEPTH + l) * 2 + dir) * 4 + h) * 4096;
#pragma unroll
    for (int d = 0; d < 64; ++d) S[d] = s0[d * 64 + j];
  } else {
#pragma unroll
    for (int d = 0; d < 64; ++d) S[d] = 0.f;
  }
  for (int s = 0; s < n; ++s) {
    int t = tbase + (dir == 0 ? s : n - 1 - s);
    const float* zr = Z + (size_t)t * INW;
    float vj = zr[C_VC + h * 64 + j];
    float o = 0.f;
#pragma unroll
    for (int d = 0; d < 64; ++d) {
      float kd = zr[C_KC + h * 64 + d] * 0.125f;
      float qd = zr[C_QC + h * 64 + d];
      S[d] = gamma * S[d] + kd * vj;
      o += qd * S[d];
    }
    OFB[((size_t)dir * T + t) * 256 + h * 64 + j] = o;
  }
  if (!lat) {
    float* so = out + O_NS + ((size_t)((seq * DEPTH + l) * 2 + dir) * 4 + h) * 4096;
#pragma unroll
    for (int d = 0; d < 64; ++d) so[d * 64 + j] = S[d];
  }
}
__global__ void __launch_bounds__(256) ret_combine_kernel(const float* Z, const float* OFB, float* MIXCAT) {
  int t = blockIdx.x, cidx = threadIdx.x;
  float o = OFB[(size_t)t * 256 + cidx] + OFB[((size_t)T + t) * 256 + cidx];
  float mu = wave_sum(o) * (1.f / 64.f);
  float dv = o - mu;
  float var = wave_sum(dv * dv) * (1.f / 64.f);
  float y = dv * rsqrtf(var + LN_EPS);
  MIXCAT[(size_t)t * D + 512 + cidx] = y * silu_f(Z[(size_t)t * INW + C_GC + cidx]);
}

__global__ void __launch_bounds__(256) conv_kernel(In in, const float* Z, float* MIXCAT, int l) {
  __shared__ float red[4];
  int t = blockIdx.x, ch = threadIdx.x;
  bool lat = t >= TCTX;
  int n = lat ? ((t - TCTX) & 1023) : (t & 255);
  int len = lat ? 1024 : 256;
  int tbase = t - n;
  float acc = in.conv_b[l * 256 + ch];
  for (int j = 0; j < 31; ++j) {
    int m = n - 15 + j;
    if (m < 0 || m >= len) continue;
    const float* zr = Z + (size_t)(tbase + m) * INW;
    float hv = zr[C_AD + ch] * sigmoid_f(zr[C_BD + ch]);
    acc += in.conv_w[((size_t)l * 31 + j) * 256 + ch] * hv;
  }
  float mu = block_sum256(acc, red) * (1.f / 256.f);
  float dv = acc - mu;
  float var = block_sum256(dv * dv, red) * (1.f / 256.f);
  float y = dv * rsqrtf(var + LN_EPS) * in.conv_ln_g[l * 256 + ch] + in.conv_ln_b[l * 256 + ch];
  MIXCAT[(size_t)t * D + 768 + ch] = silu_f(y);
}

__global__ void __launch_bounds__(256) ln1_kernel(In in, const float* X, const float* MIX, const float* mod_l,
                                                  float* X1, float* H2, int l) {
  __shared__ float red[4];
  int t = blockIdx.x, tid = threadIdx.x;
  const float* m = mod_l + (size_t)cond_of(t) * 6144;
  float v[4];
  float s = 0.f;
#pragma unroll
  for (int i = 0; i < 4; ++i) {
    int d = i * 256 + tid;
    v[i] = ALPHA * X[(size_t)t * D + d] + m[2048 + d] * MIX[(size_t)t * D + d];
    s += v[i];
  }
  float mu = block_sum256(s, red) * (1.f / 1024.f);
  float sq = 0.f;
#pragma unroll
  for (int i = 0; i < 4; ++i) { v[i] -= mu; sq += v[i] * v[i]; }
  float var = block_sum256(sq, red) * (1.f / 1024.f);
  float r = rsqrtf(var + LN_EPS);
#pragma unroll
  for (int i = 0; i < 4; ++i) {
    int d = i * 256 + tid;
    float x1 = v[i] * r * in.ln1_g[l * D + d] + in.ln1_b[l * D + d];
    X1[(size_t)t * D + d] = x1;
    H2[(size_t)t * D + d] = x1 * (1.f + m[4096 + d]) + m[3072 + d];
  }
}

#define INS16(V, I, xv, xi)                                         \
  {                                                                 \
    float _x = (xv); int _xi = (xi);                                \
    _Pragma("unroll") for (int _i = 0; _i < 16; ++_i) {             \
      bool _gt = _x > V[_i];                                        \
      float _tv = _gt ? V[_i] : _x; int _ti = _gt ? I[_i] : _xi;    \
      V[_i] = _gt ? _x : V[_i]; I[_i] = _gt ? _xi : I[_i];          \
      _x = _tv; _xi = _ti;                                          \
    }                                                               \
  }
__global__ void __launch_bounds__(64) topk_kernel(In in, const float* Q, int* EIDX, float* GATE, int l) {
  __shared__ float sv[2][16][64];
  __shared__ int si[2][16][64];
  int gid = blockIdx.x * 64 + threadIdx.x;
  int t = gid >> 3, h = gid & 7;
  int tx = threadIdx.x;
  for (int p = 0; p < 2; ++p) {
    float q[64];
    const float* qp = Q + (size_t)t * D + h * 128 + p * 64;
#pragma unroll
    for (int d = 0; d < 64; ++d) q[d] = qp[d];
    float V[16]; int I[16];
#pragma unroll
    for (int i = 0; i < 16; ++i) { V[i] = -3.0e38f; I[i] = 0; }
    const float* kb = in.peer_keys + ((size_t)(l * 2 + p) * 128) * 64;
    for (int k = 0; k < 128; ++k) {
      float s = 0.f;
#pragma unroll
      for (int d = 0; d < 64; ++d) s += q[d] * kb[k * 64 + d];
      INS16(V, I, s, k);
    }
#pragma unroll
    for (int i = 0; i < 16; ++i) { sv[p][i][tx] = V[i]; si[p][i][tx] = I[i]; }
  }
  float V[16]; int I[16];
#pragma unroll
  for (int i = 0; i < 16; ++i) { V[i] = -3.0e38f; I[i] = 0; }
  for (int i = 0; i < 16; ++i) {
    float a = sv[0][i][tx];
    for (int j = 0; j < 16; ++j) {
      float c = a + sv[1][j][tx];
      INS16(V, I, c, i * 16 + j);
    }
  }
  float mx = V[0];
  float e[16], sum = 0.f;
#pragma unroll
  for (int i = 0; i < 16; ++i) { e[i] = expf(V[i] - mx); sum += e[i]; }
  float inv = 1.f / sum;
#pragma unroll
  for (int i = 0; i < 16; ++i) {
    int ci = I[i];
    int ei = si[0][ci >> 4][tx] * 128 + si[1][ci & 15][tx];
    EIDX[(size_t)t * 128 + h * 16 + i] = ei;
    GATE[(size_t)t * 128 + h * 16 + i] = e[i] * inv;
  }
}

__global__ void __launch_bounds__(256) peer_kernel(In in, const float* X1, const float* H2, const int* EIDX,
                                                   const float* GATE, const float* mod_l, float* Xout, float* Yout, int l) {
  __shared__ float wgt[128];
  __shared__ float red[4];
  int t = blockIdx.x, tid = threadIdx.x, lane = tid & 63, w = tid >> 6;
  const float* U = in.peer_u + (size_t)l * 16384 * D;
  const float* Vt = in.peer_v + (size_t)l * 16384 * D;
  float4 xh[4];
#pragma unroll
  for (int i = 0; i < 4; ++i) xh[i] = *(const float4*)&H2[(size_t)t * D + i * 256 + lane * 4];
  for (int e = w; e < 128; e += 4) {
    int ei = EIDX[(size_t)t * 128 + e];
    const float* ur = U + (size_t)ei * D;
    float s = 0.f;
#pragma unroll
    for (int i = 0; i < 4; ++i) {
      float4 u = *(const float4*)&ur[i * 256 + lane * 4];
      s += u.x * xh[i].x + u.y * xh[i].y + u.z * xh[i].z + u.w * xh[i].w;
    }
    s = wave_sum(s);
    if (lane == 0) wgt[e] = GATE[(size_t)t * 128 + e] * gelu_f(s);
  }
  __syncthreads();
  float4 f = make_float4(0.f, 0.f, 0.f, 0.f);
  for (int e = 0; e < 128; ++e) {
    int ei = EIDX[(size_t)t * 128 + e];
    float we = wgt[e];
    float4 v = *(const float4*)&Vt[(size_t)ei * D + tid * 4];
    f.x += we * v.x; f.y += we * v.y; f.z += we * v.z; f.w += we * v.w;
  }
  const float* m = mod_l + (size_t)cond_of(t) * 6144;
  float4 x1 = *(const float4*)&X1[(size_t)t * D + tid * 4];
  float4 g2 = *(const float4*)&m[5120 + tid * 4];
  float v0 = ALPHA * x1.x + g2.x * f.x, v1 = ALPHA * x1.y + g2.y * f.y, v2 = ALPHA * x1.z + g2.z * f.z,
        v3 = ALPHA * x1.w + g2.w * f.w;
  float mu = block_sum256(v0 + v1 + v2 + v3, red) * (1.f / 1024.f);
  v0 -= mu; v1 -= mu; v2 -= mu; v3 -= mu;
  float var = block_sum256(v0 * v0 + v1 * v1 + v2 * v2 + v3 * v3, red) * (1.f / 1024.f);
  float r = rsqrtf(var + LN_EPS);
  float4 g = *(const float4*)&in.ln2_g[l * D + tid * 4];
  float4 b = *(const float4*)&in.ln2_b[l * D + tid * 4];
  float4 o = make_float4(v0 * r * g.x + b.x, v1 * r * g.y + b.y, v2 * r * g.z + b.z, v3 * r * g.w + b.w);
  *(float4*)&Xout[(size_t)t * D + tid * 4] = o;
  if (Yout) *(float4*)&Yout[(size_t)t * D + tid * 4] = o;
}

extern "C" void kernel_launch(void* const* d_in, const int* in_sizes, int n_in, void* d_out, int out_size,
                              void* d_ws, size_t ws_size, hipStream_t stream) {
  In in;
  const float** ip = (const float**)&in;
  for (int i = 0; i < 30; ++i) ip[i] = (const float*)d_in[i];
  float* out = (float*)d_out;
  float* ws = (float*)d_ws;
  size_t off = 0;
  auto take = [&](size_t n) { float* p = ws + off; off += (n + 63) & ~(size_t)63; return p; };
  float* MOD = take((size_t)DEPTH * NCOND * 6144);
  float2* ROPE = (float2*)take(1024);
  float* X = take((size_t)T * D);
  float* H = take((size_t)T * D);
  float* Z = take((size_t)T * INW);
  float* MIXCAT = take((size_t)T * D);
  float* MIX = take((size_t)T * D);
  float* X1 = take((size_t)T * D);
  float* H2 = take((size_t)T * D);
  float* Q = take((size_t)T * D);
  float* QR = take((size_t)8192 * 256);
  float* KR = take((size_t)8192 * 256);
  float* GV = take((size_t)T * 256);
  float* OFB = take((size_t)2 * T * 256);
  int* EIDX = (int*)take((size_t)T * 128);
  float* GATE = take((size_t)T * 128);

  hipMemcpyAsync(X, in.x_prompt, (size_t)TCTX * D * 4, hipMemcpyDeviceToDevice, stream);
  hipMemcpyAsync(X + (size_t)TCTX * D, in.x_sample, (size_t)TCTX * D * 4, hipMemcpyDeviceToDevice, stream);
  mod_kernel<<<(DEPTH * NCOND * 6144 + 255) / 256, 256, 0, stream>>>(in, MOD);
  rope_table_kernel<<<1, 512, 0, stream>>>(ROPE);
  for (int l = 0; l < DEPTH; ++l) {
    const float* mod_l = MOD + (size_t)l * NCOND * 6144;
    modulate_kernel<<<T * D / 256, 256, 0, stream>>>(X, mod_l, H);
    sgemm_kernel<<<dim3(INW / 64, T / 64), 256, 0, stream>>>(H, in.w_in + (size_t)l * D * INW, Z, T, INW, D);
    kv_out_kernel<<<TCTX * 256 / 256, 256, 0, stream>>>(Z, out, l);
    rope_qk_kernel<<<8192 * 256 / 256, 256, 0, stream>>>(Z, ROPE, QR, KR);
    attn_naive_kernel<<<1024, 64, 0, stream>>>(in, Z, QR, KR, MIXCAT, l);
    gmlp_ln_kernel<<<T, 256, 0, stream>>>(in, Z, GV, l);
    gmlp_mix_kernel<<<T, 256, 0, stream>>>(in, Z, GV, MIXCAT, l);
    ret_scan_kernel<<<320, 64, 0, stream>>>(in, Z, OFB, out, l);
    ret_combine_kernel<<<T, 256, 0, stream>>>(Z, OFB, MIXCAT);
    conv_kernel<<<T, 256, 0, stream>>>(in, Z, MIXCAT, l);
    sgemm_kernel<<<dim3(D / 64, T / 64), 256, 0, stream>>>(MIXCAT, in.w_out + (size_t)l * D * D, MIX, T, D, D);
    ln1_kernel<<<T, 256, 0, stream>>>(in, X, MIX, mod_l, X1, H2, l);
    sgemm_kernel<<<dim3(D / 64, T / 64), 256, 0, stream>>>(H2, in.peer_wq + (size_t)l * D * D, Q, T, D, D);
    topk_kernel<<<T * 8 / 64, 64, 0, stream>>>(in, Q, EIDX, GATE, l);
    peer_kernel<<<T, 256, 0, stream>>>(in, X1, H2, EIDX, GATE, mod_l, X, l == DEPTH - 1 ? out : nullptr, l);
  }
}
```

```cpp
#include <hip/hip_runtime.h>
#include <hip/hip_cooperative_groups.h>
#include <stdint.h>
#include <cstdio>
namespace cg = cooperative_groups;

constexpr int D = 1024;
constexpr int T = 16384;
constexpr int TCTX = 8192;
constexpr int INW = 2816;
constexpr int DEPTH = 4;
constexpr int NCOND = 9;
constexpr float LN_EPS = 1e-5f;
constexpr float ALPHA = 1.681792830507429f;

constexpr int C_QA = 0, C_KA = 256, C_VA = 512, C_UB = 768, C_VB = 1024, C_QC = 1280, C_KC = 1536,
              C_VC = 1792, C_GC = 2048, C_AD = 2304, C_BD = 2560;

constexpr size_t O_YP = 0, O_YS = 8388608, O_NK = 16777216, O_NV = 25165824, O_NS = 33554432;

struct In {
  const float *x_prompt, *x_sample, *cache_k, *cache_v, *state_ret, *c, *c_ctx, *w_mod, *b_mod, *w_in,
      *diff_lambda, *diff_subln_g, *gmlp_ln_g, *gmlp_ln_b, *gmlp_ws, *gmlp_bs, *ret_decay, *conv_w, *conv_b,
      *conv_ln_g, *conv_ln_b, *w_out, *ln1_g, *ln1_b, *ln2_g, *ln2_b, *peer_wq, *peer_keys, *peer_u, *peer_v;
};

__device__ __forceinline__ float sigmoid_f(float x) { return 1.f / (1.f + expf(-x)); }
__device__ __forceinline__ float silu_f(float x) { return x * sigmoid_f(x); }
__device__ __forceinline__ float gelu_f(float x) {
  float u = 0.7978845608028654f * (x + 0.044715f * x * x * x);
  return x * sigmoid_f(2.f * u);
}
__device__ __forceinline__ int cond_of(int t) { return t < TCTX ? 0 : 1 + ((t - TCTX) >> 10); }
__device__ __forceinline__ float lam_init(int l) { return 0.8f - 0.6f * expf(-0.3f * (float)l); }

__device__ __forceinline__ float wave_sum(float v) {
#pragma unroll
  for (int o = 32; o > 0; o >>= 1) v += __shfl_xor(v, o);
  return v;
}
__device__ __forceinline__ float block_sum256(float v, float* red) {
  v = wave_sum(v);
  __syncthreads();
  if ((threadIdx.x & 63) == 0) red[threadIdx.x >> 6] = v;
  __syncthreads();
  return red[0] + red[1] + red[2] + red[3];
}

typedef unsigned short bf16_t;
using bf16x8 = __attribute__((ext_vector_type(8))) short;
using f32x4 = __attribute__((ext_vector_type(4))) float;
__device__ __forceinline__ bf16_t f2bf(float f) {
  unsigned u = __float_as_uint(f);
  u += 0x7fffu + ((u >> 16) & 1u);
  return (bf16_t)(u >> 16);
}
__device__ __forceinline__ unsigned pack2bf(float a, float b) { return (unsigned)f2bf(a) | ((unsigned)f2bf(b) << 16); }
__device__ __forceinline__ float bf2f(bf16_t h) { return __uint_as_float(((unsigned)h) << 16); }
__device__ __forceinline__ void ld16(const float* s, float* v) {
  float4 a = *(const float4*)s, b = *(const float4*)(s + 4), c = *(const float4*)(s + 8), d = *(const float4*)(s + 12);
  v[0] = a.x; v[1] = a.y; v[2] = a.z; v[3] = a.w; v[4] = b.x; v[5] = b.y; v[6] = b.z; v[7] = b.w;
  v[8] = c.x; v[9] = c.y; v[10] = c.z; v[11] = c.w; v[12] = d.x; v[13] = d.y; v[14] = d.z; v[15] = d.w;
}
__device__ __forceinline__ void ld8(const float* s, float* v) {
  float4 a = *(const float4*)s, b = *(const float4*)(s + 4);
  v[0] = a.x; v[1] = a.y; v[2] = a.z; v[3] = a.w; v[4] = b.x; v[5] = b.y; v[6] = b.z; v[7] = b.w;
}
__device__ __forceinline__ void ld8b(const bf16_t* s, float* v) {
  uint4 q = *(const uint4*)s;
  v[0] = __uint_as_float(q.x << 16); v[1] = __uint_as_float(q.x & 0xffff0000u); v[2] = __uint_as_float(q.y << 16); v[3] = __uint_as_float(q.y & 0xffff0000u);
  v[4] = __uint_as_float(q.z << 16); v[5] = __uint_as_float(q.z & 0xffff0000u); v[6] = __uint_as_float(q.w << 16); v[7] = __uint_as_float(q.w & 0xffff0000u);
}
__device__ __forceinline__ void ld16b(const bf16_t* s, float* v) { ld8b(s, v); ld8b(s + 8, v + 8); }
__device__ __forceinline__ int ksw(int row, int chunk) { return row * 128 + ((chunk ^ ((row >> 1) & 7)) << 4); }
__device__ __forceinline__ int otid(int wbase) {
  int t = wbase + (int)__builtin_amdgcn_mbcnt_hi(~0u, __builtin_amdgcn_mbcnt_lo(~0u, 0u));
  asm volatile("" : "+v"(t));
  return t;
}

struct P {
  In in;
  float* out;
  float *MOD, *X, *MIX, *X1, *GATE, *LN1S;
  bf16_t* Z;
  bf16_t *Hb, *MIXCATb, *H2b, *WinT, *WoutT, *WqT, *Qb, *KEYSb, *CKb, *CVb, *MIXb, *Xb;
  unsigned char *U8, *V8;
  float *USC, *VSC;
  float2* ROPE;
  int* EIDX;
  unsigned* BAR;
  int use_cg_sync;
  int pad_;
};

#define FOR_VB(G) for (int vb = blockIdx.x; vb < (G); vb += gridDim.x)


__device__ void rope_table_phase(const P& p) {
  FOR_VB(2) {
    int idx = vb * 256 + threadIdx.x;
    int pos = idx >> 3, i = idx & 7;
    float inv = powf(10000.f, -(float)i / 8.f);
    float angf = (float)pos * inv;
    double x = (double)angf;
    double kq = rint(x * 0.6366197723675814);
    double r = x - kq * 1.5707963267948966;
    double r2 = r * r;
    double s = r * (1.0 + r2 * (-1.0 / 6 + r2 * (1.0 / 120 + r2 * (-1.0 / 5040 + r2 * (1.0 / 362880 + r2 * (-1.0 / 39916800 + r2 * (1.0 / 6227020800.0)))))));
    double c = 1.0 + r2 * (-0.5 + r2 * (1.0 / 24 + r2 * (-1.0 / 720 + r2 * (1.0 / 40320 + r2 * (-1.0 / 3628800 + r2 * (1.0 / 479001600.0 + r2 * (-1.0 / 87178291200.0)))))));
    int q = ((int)kq) & 3;
    double cs, sn;
    if (q == 0) { cs = c; sn = s; }
    else if (q == 1) { cs = -s; sn = c; }
    else if (q == 2) { cs = -c; sn = -s; }
    else { cs = s; sn = -c; }
    p.ROPE[idx] = make_float2((float)cs, (float)sn);
  }
}

__device__ void copy_x_phase(const P& p) {
  for (size_t i = (size_t)blockIdx.x * 256 + threadIdx.x; i < (size_t)T * D / 4; i += (size_t)gridDim.x * 256) {
    size_t e = i * 4;
    float4 v = e < (size_t)TCTX * D ? *(const float4*)&p.in.x_prompt[e] : *(const float4*)&p.in.x_sample[e - (size_t)TCTX * D];
    *(float4*)&p.X[e] = v;
  }
}

__device__ void modulate_phase(const P& p, int l) {
  const float* mod_l = p.MOD + (size_t)l * NCOND * 6144;
  for (size_t idx = (size_t)blockIdx.x * 256 + threadIdx.x; idx < (size_t)T * D; idx += (size_t)gridDim.x * 256) {
    int t = (int)(idx >> 10), d = (int)(idx & 1023);
    const float* m = mod_l + (size_t)cond_of(t) * 6144;
    const float xv = idx < (size_t)TCTX * D ? p.in.x_prompt[idx] : p.in.x_sample[idx - (size_t)TCTX * D];
    p.Hb[idx] = f2bf(xv * (1.f + m[1024 + d]) + m[d]);
  }
}


template <int CTRL, int ROWMASK>
__device__ __forceinline__ float dpp_add(float v) {
  int t = __builtin_amdgcn_update_dpp(0, __float_as_int(v), CTRL, ROWMASK, 0xf, false);
  return v + __int_as_float(t);
}
__device__ __forceinline__ float wave_sum_u(float v) {
  v = dpp_add<0xB1, 0xf>(v);
  v = dpp_add<0x4E, 0xf>(v);
  v = dpp_add<0x141, 0xf>(v);
  v = dpp_add<0x140, 0xf>(v);
  v = dpp_add<0x142, 0xa>(v);
  v = dpp_add<0x143, 0xc>(v);
  return __int_as_float(__builtin_amdgcn_readlane(__float_as_int(v), 63));
}
typedef __attribute__((ext_vector_type(2))) __bf16 bf2_t;
__device__ __forceinline__ float dot2bf(unsigned a, unsigned b, float acc) {
  return __builtin_amdgcn_fdot2_f32_bf16(__builtin_bit_cast(bf2_t, a), __builtin_bit_cast(bf2_t, b), acc, false);
}
__device__ __forceinline__ float dot8bf(uint4 a, uint4 b, float acc) {
  acc = dot2bf(a.x, b.x, acc); acc = dot2bf(a.y, b.y, acc); acc = dot2bf(a.z, b.z, acc); acc = dot2bf(a.w, b.w, acc);
  return acc;
}
__device__ __forceinline__ float bflo(unsigned x) { return __uint_as_float(x << 16); }
__device__ __forceinline__ float bfhi(unsigned x) { return __uint_as_float(x & 0xffff0000u); }

#define INS16(V, I, xv, xi)                                         \
  {                                                                 \
    float _x = (xv); int _xi = (xi);                                \
    _Pragma("unroll") for (int _i = 0; _i < 16; ++_i) {             \
      bool _gt = _x > V[_i];                                        \
      float _tv = _gt ? V[_i] : _x; int _ti = _gt ? I[_i] : _xi;    \
      V[_i] = _gt ? _x : V[_i]; I[_i] = _gt ? _xi : I[_i];          \
      _x = _tv; _xi = _ti;                                          \
    }                                                               \
  }


__device__ void wtrans_phase(const P& p, char* smem, const int g_wbase) {
  float(*tile)[65] = (float(*)[65])smem;
  const int tid = otid(g_wbase);
  FOR_VB(DEPTH * 1216) {
    int l = vb / 1216, r = vb % 1216;
    const float* W; bf16_t* Wt; int N, it;
    if (r < 704) { W = p.in.w_in + (size_t)l * D * INW; Wt = p.WinT + (size_t)l * INW * D; N = INW; it = r; }
    else if (r < 960) { W = p.in.w_out + (size_t)l * D * D; Wt = p.WoutT + (size_t)l * D * D; N = D; it = r - 704; }
    else { W = p.in.peer_wq + (size_t)l * D * D; Wt = p.WqT + (size_t)l * D * D; N = D; it = r - 960; }
    int ntn = N / 64;
    int k0 = (it / ntn) * 64, n0 = (it % ntn) * 64;
    __syncthreads();
#pragma unroll
    for (int i = 0; i < 4; ++i) {
      int e = i * 256 + tid;
      int kr = e >> 4, c4 = e & 15;
      float4 v = *(const float4*)&W[(size_t)(k0 + kr) * N + n0 + c4 * 4];
      tile[kr][c4 * 4 + 0] = v.x; tile[kr][c4 * 4 + 1] = v.y; tile[kr][c4 * 4 + 2] = v.z; tile[kr][c4 * 4 + 3] = v.w;
    }
    __syncthreads();
#pragma unroll
    for (int i = 0; i < 2; ++i) {
      int e = i * 256 + tid;
      int nr = e >> 3, kc = e & 7;
      bf16x8 o;
#pragma unroll
      for (int j = 0; j < 8; ++j) o[j] = (short)f2bf(tile[kc * 8 + j][nr]);
      const int n_ = n0 + nr, k_ = k0 + kc * 8;
      *(bf16x8*)&Wt[((size_t)((n_ >> 4) * 32 + (k_ >> 5)) * 512) + ((((k_ >> 3) & 3) * 16 + (n_ & 15)) * 8)] = o;
    }
  }
}

using f32x16 = __attribute__((ext_vector_type(16))) float;
__device__ __forceinline__ int sortable_i(float f) { int u = __float_as_int(f); return u ^ ((u >> 31) & 0x7fffffff); }
__device__ __forceinline__ float unsortable_f(int s) { return __int_as_float(s ^ ((s >> 31) & 0x7fffffff)); }
__device__ __forceinline__ void ce_desc(int& a, int& b) { int hi = max(a, b), lo = min(a, b); a = hi; b = lo; }
__device__ __forceinline__ void sort16_desc(int (&a)[16]) {
#pragma unroll
  for (int k = 2; k <= 16; k <<= 1)
#pragma unroll
    for (int j = k >> 1; j > 0; j >>= 1)
#pragma unroll
      for (int i = 0; i < 16; ++i) {
        const int q = i ^ j;
        if (q > i) { if ((i & k) == 0) ce_desc(a[i], a[q]); else ce_desc(a[q], a[i]); }
      }
}
__device__ __forceinline__ void bmerge16_desc(int (&a)[16]) {
#pragma unroll
  for (int j = 8; j > 0; j >>= 1)
#pragma unroll
    for (int i = 0; i < 16; ++i) { const int q = i ^ j; if (q > i) ce_desc(a[i], a[q]); }
}
__device__ __forceinline__ void top16_merge(int (&a)[16], const int (&b)[16]) {
#pragma unroll
  for (int i = 0; i < 16; ++i) a[i] = max(a[i], b[15 - i]);
  bmerge16_desc(a);
}
__device__ __forceinline__ void acc_keys(const f32x16& acc, int kb, int hh4, int (&a)[16]) {
#pragma unroll
  for (int i = 0; i < 16; ++i) a[i] = (sortable_i(acc[i]) & ~127) | (32 * kb + (i & 3) + 8 * (i >> 2)) | hh4;
}

constexpr int candI(int s) {
  int c = 0;
  for (int i = 0; i < 16; ++i) for (int j = 0; j < 16; ++j) if ((i + 1) * (j + 1) <= 16) { if (c == s) return i * 16 + j; ++c; }
  return -1;
}
template <int G>
__device__ __forceinline__ void cand_group(const float (&va)[16], const float (&vb)[16], int (&c)[16]) {
#pragma unroll
  for (int s = 0; s < 16; ++s) {
    constexpr int dummy = 0; (void)dummy;
    const int ij = candI(G * 16 + s);
    if (ij < 0) c[s] = (int)0x80000000;
    else c[s] = (sortable_i(va[ij >> 4] + vb[ij & 15]) & ~255) | ij;
  }
}

__device__ void topk_fast_phase(const P& p, int l, char* smem, const int g_wbase) {
  const int tid = otid(g_wbase), lane = tid & 63, w = tid >> 6, hh = lane >> 5, tk = lane & 31;
  __syncthreads();
  {
    const bf16_t* kb = p.KEYSb + (size_t)l * 2 * 128 * 64;
    for (int i = tid; i < 2048; i += 256) {
      int half = i >> 10, r = (i >> 3) & 127, c = i & 7;
      *(bf16x8*)(smem + half * 16384 + ksw(r, c)) = *(const bf16x8*)(kb + (size_t)(half * 128 + r) * 64 + c * 8);
    }
  }
  __syncthreads();
  unsigned char* IDX = (unsigned char*)(smem + 32768) + w * 1024;
  for (int item = blockIdx.x * 4 + w; item < 512 * 8; item += gridDim.x * 4) {
    const int tile = item >> 3, h = item & 7;
    const int t = tile * 32 + tk;
    int tk0[16], tk1[16];
#pragma unroll
    for (int pp = 0; pp < 2; ++pp) {
      f32x16 acc[4];
#pragma unroll
      for (int kb = 0; kb < 4; ++kb)
#pragma unroll
        for (int i = 0; i < 16; ++i) acc[kb][i] = 0.f;
#pragma unroll
      for (int ks = 0; ks < 4; ++ks) {
        bf16x8 bq = *(const bf16x8*)&p.Qb[(size_t)t * D + h * 128 + pp * 64 + ks * 16 + hh * 8];
#pragma unroll
        for (int kb = 0; kb < 4; ++kb) {
          bf16x8 ak = *(const bf16x8*)(smem + pp * 16384 + ksw(32 * kb + tk, 2 * ks + hh));
          acc[kb] = __builtin_amdgcn_mfma_f32_32x32x16_bf16(ak, bq, acc[kb], 0, 0, 0);
        }
      }
      int a[16], b[16];
      acc_keys(acc[0], 0, hh * 4, a); sort16_desc(a);
      acc_keys(acc[1], 1, hh * 4, b); sort16_desc(b); top16_merge(a, b);
      acc_keys(acc[2], 2, hh * 4, b); sort16_desc(b); top16_merge(a, b);
      acc_keys(acc[3], 3, hh * 4, b); sort16_desc(b); top16_merge(a, b);
#pragma unroll
      for (int i = 0; i < 16; ++i) b[i] = __shfl_xor(a[i], 32);
      top16_merge(a, b);
#pragma unroll
      for (int i = 0; i < 16; ++i) { if (pp == 0) tk0[i] = a[i]; else tk1[i] = a[i]; }
    }
    {
      unsigned pk[4];
#pragma unroll
      for (int q4 = 0; q4 < 4; ++q4) {
        unsigned x = 0;
#pragma unroll
        for (int b4 = 0; b4 < 4; ++b4) {
          int i = q4 * 4 + b4;
          unsigned v = (unsigned)((hh ? tk1[i] : tk0[i]) & 127);
          x |= v << (8 * b4);
        }
        pk[q4] = x;
      }
      *(uint4*)(IDX + tk * 32 + hh * 16) = make_uint4(pk[0], pk[1], pk[2], pk[3]);
    }
    float va[16], vb[16];
#pragma unroll
    for (int i = 0; i < 16; ++i) { va[i] = unsortable_f(tk0[i] & ~127); vb[i] = unsortable_f(tk1[i] & ~127); }
    int c[16], d[16];
    cand_group<0>(va, vb, c); sort16_desc(c);
    cand_group<1>(va, vb, d); sort16_desc(d); top16_merge(c, d);
    cand_group<2>(va, vb, d); sort16_desc(d); top16_merge(c, d);
    cand_group<3>(va, vb, d); sort16_desc(d); top16_merge(c, d);
    __builtin_amdgcn_wave_barrier();
    float e[16], sum = 0.f;
    const float m0 = unsortable_f(c[0] & ~255);
#pragma unroll
    for (int i = 0; i < 16; ++i) { e[i] = expf(unsortable_f(c[i] & ~255) - m0); sum += e[i]; }
    const float inv = 1.f / sum;
    if (hh == 0) {
      int ex[16];
#pragma unroll
      for (int i = 0; i < 16; ++i) {
        const int ci = c[i] & 255;
        ex[i] = (int)IDX[tk * 32 + (ci >> 4)] * 128 + (int)IDX[tk * 32 + 16 + (ci & 15)];
      }
      int4* dst = (int4*)&p.EIDX[(size_t)t * 128 + h * 16];
      dst[0] = make_int4(ex[0], ex[1], ex[2], ex[3]); dst[1] = make_int4(ex[4], ex[5], ex[6], ex[7]);
      dst[2] = make_int4(ex[8], ex[9], ex[10], ex[11]); dst[3] = make_int4(ex[12], ex[13], ex[14], ex[15]);
    } else {
      float4* dst = (float4*)&p.GATE[(size_t)t * 128 + h * 16];
      dst[0] = make_float4(e[0] * inv, e[1] * inv, e[2] * inv, e[3] * inv);
      dst[1] = make_float4(e[4] * inv, e[5] * inv, e[6] * inv, e[7] * inv);
      dst[2] = make_float4(e[8] * inv, e[9] * inv, e[10] * inv, e[11] * inv);
      dst[3] = make_float4(e[12] * inv, e[13] * inv, e[14] * inv, e[15] * inv);
    }
    __builtin_amdgcn_wave_barrier();
  }
}

__device__ __forceinline__ void topk_tile(const P& p, const char* QL, const char* KL, unsigned char* IDX, int t0, int h, int lane, int w) {
  asm volatile("" : "+v"(lane));
  const int hh = lane >> 5, tk = lane & 31;
  const int qrow = 32 * w + tk;
  const int t = t0 + qrow;
  {
    int tk0[16], tk1[16];
#pragma unroll
    for (int pp = 0; pp < 2; ++pp) {
      bf16x8 bq[4];
#pragma unroll
      for (int ks = 0; ks < 4; ++ks) bq[ks] = *(const bf16x8*)(QL + qrow * 256 + (((pp * 8 + ks * 2 + hh) ^ (qrow & 15)) << 4));
      int a[16], b[16];
#pragma unroll
      for (int kb = 0; kb < 4; ++kb) {
        f32x16 acc;
#pragma unroll
        for (int i = 0; i < 16; ++i) acc[i] = 0.f;
#pragma unroll
        for (int ks = 0; ks < 4; ++ks) {
          bf16x8 ak = *(const bf16x8*)(KL + pp * 16384 + ksw(32 * kb + tk, 2 * ks + hh));
          acc = __builtin_amdgcn_mfma_f32_32x32x16_bf16(ak, bq[ks], acc, 0, 0, 0);
        }
        if (kb == 0) { acc_keys(acc, 0, hh * 4, a); sort16_desc(a); }
        else { acc_keys(acc, kb, hh * 4, b); sort16_desc(b); top16_merge(a, b); }
      }
#pragma unroll
      for (int i = 0; i < 16; ++i) b[i] = __shfl_xor(a[i], 32);
      top16_merge(a, b);
#pragma unroll
      for (int i = 0; i < 16; ++i) { if (pp == 0) tk0[i] = a[i]; else tk1[i] = a[i]; }
    }
    {
      unsigned pk[4];
#pragma unroll
      for (int q4 = 0; q4 < 4; ++q4) {
        unsigned x = 0;
#pragma unroll
        for (int b4 = 0; b4 < 4; ++b4) {
          int i = q4 * 4 + b4;
          unsigned v = (unsigned)((hh ? tk1[i] : tk0[i]) & 127);
          x |= v << (8 * b4);
        }
        pk[q4] = x;
      }
      *(uint4*)(IDX + tk * 32 + hh * 16) = make_uint4(pk[0], pk[1], pk[2], pk[3]);
    }
    float va[16], vb[16];
#pragma unroll
    for (int i = 0; i < 16; ++i) { va[i] = unsortable_f(tk0[i] & ~127); vb[i] = unsortable_f(tk1[i] & ~127); }
    int c[16], d[16];
    cand_group<0>(va, vb, c); sort16_desc(c);
    cand_group<1>(va, vb, d); sort16_desc(d); top16_merge(c, d);
    cand_group<2>(va, vb, d); sort16_desc(d); top16_merge(c, d);
    cand_group<3>(va, vb, d); sort16_desc(d); top16_merge(c, d);
    __builtin_amdgcn_wave_barrier();
    float e[16], sum = 0.f;
    const float m0 = unsortable_f(c[0] & ~255);
#pragma unroll
    for (int i = 0; i < 16; ++i) { e[i] = expf(unsortable_f(c[i] & ~255) - m0); sum += e[i]; }
    const float inv = 1.f / sum;
    if (hh == 0) {
      int ex[16];
#pragma unroll
      for (int i = 0; i < 16; ++i) {
        const int ci = c[i] & 255;
        ex[i] = (int)IDX[tk * 32 + (ci >> 4)] * 128 + (int)IDX[tk * 32 + 16 + (ci & 15)];
      }
      int4* dst = (int4*)&p.EIDX[(size_t)t * 128 + h * 16];
      dst[0] = make_int4(ex[0], ex[1], ex[2], ex[3]); dst[1] = make_int4(ex[4], ex[5], ex[6], ex[7]);
      dst[2] = make_int4(ex[8], ex[9], ex[10], ex[11]); dst[3] = make_int4(ex[12], ex[13], ex[14], ex[15]);
    } else {
      float4* dst = (float4*)&p.GATE[(size_t)t * 128 + h * 16];
      dst[0] = make_float4(e[0] * inv, e[1] * inv, e[2] * inv, e[3] * inv);
      dst[1] = make_float4(e[4] * inv, e[5] * inv, e[6] * inv, e[7] * inv);
      dst[2] = make_float4(e[8] * inv, e[9] * inv, e[10] * inv, e[11] * inv);
      dst[3] = make_float4(e[12] * inv, e[13] * inv, e[14] * inv, e[15] * inv);
    }
    __builtin_amdgcn_wave_barrier();
  }
}

__device__ __forceinline__ void glds16(const void* g, void* lds) {
  __builtin_amdgcn_global_load_lds((const unsigned*)g, (unsigned*)lds, 16, 0, 0);
}
template <int EPI>
__device__ void gemm_phase(const P& p, int l, const bf16_t* __restrict__ A, const bf16_t* __restrict__ Bt, float* __restrict__ C, bf16_t* __restrict__ Cb, int N, char* smem, const int g_wbase) {
  const int tid = otid(g_wbase), lane = tid & 63, w = tid >> 6, wr = w >> 1, wc = w & 1;
  constexpr int K = 1024;
  const int ntn = N / 128;
  const int xq = blockIdx.x & 7, rk = blockIdx.x >> 3, bpx = gridDim.x >> 3;
  const int ncg = (ntn + 7) >> 3;
  for (int lt = rk; lt < 2 * ncg * 64; lt += bpx) {
    const int g64 = lt >> 6, wi = lt & 63;
    const int tm = 16 * xq + 8 * (g64 & 1) + (wi & 7), tn = 8 * (g64 >> 1) + (wi >> 3);
    if (tn >= ntn) continue;
    const int bm = tm * 128, bn = tn * 128;
    f32x4 acc[4][4];
#pragma unroll
    for (int i = 0; i < 4; ++i)
#pragma unroll
      for (int j = 0; j < 4; ++j) acc[i][j] = f32x4{0.f, 0.f, 0.f, 0.f};
    uint4 ra0, ra1, ra2, ra3;
    bf16x8 bfA[8], bfB[8];
    const unsigned offA = (unsigned)(((bm + (tid >> 3)) * K + (((tid & 7) ^ ((tid >> 4) & 7)) << 3)) * 2);
    const unsigned offB = (unsigned)((((bn + wc * 64) >> 4) * 32) * 1024 + lane * 16);
#define GEMM_GL1(J, RA, kt) { RA = *(const uint4*)((const char*)A + (offA + (unsigned)((J) * 32 * K * 2 + (kt) * 128))); }
#define GEMM_GLOAD(kt) { GEMM_GL1(0, ra0, kt) GEMM_GL1(1, ra1, kt) GEMM_GL1(2, ra2, kt) GEMM_GL1(3, ra3, kt) }
#define GEMM_BLOAD(BF, kt)                                                                                                   \
    {                                                                                                                        \
      _Pragma("unroll") for (int i_ = 0; i_ < 4; ++i_) {                                                                     \
        BF[i_] = *(const bf16x8*)((const char*)Bt + (offB + (unsigned)((i_ * 32 + 2 * (kt)) * 1024)));                       \
        BF[4 + i_] = *(const bf16x8*)((const char*)Bt + (offB + (unsigned)((i_ * 32 + 2 * (kt) + 1) * 1024)));               \
      }                                                                                                                      \
    }
#define GEMM_LS1(J, RA, buf) { *(uint4*)(smem + (buf) * 16384 + ((J) * 256 + tid) * 16) = RA; }
#define GEMM_LSTORE(buf) { GEMM_LS1(0, ra0, buf) GEMM_LS1(1, ra1, buf) GEMM_LS1(2, ra2, buf) GEMM_LS1(3, ra3, buf) }
#define GEMM_KSTEP(kt, BC, BN, HASNEXT)                                                                                      \
    {                                                                                                                        \
      if (HASNEXT) { GEMM_GLOAD((kt) + 1) GEMM_BLOAD(BN, (kt) + 1) }                                                         \
      __builtin_amdgcn_sched_barrier(0);                                                                                     \
      const char* sa = smem + ((kt) & 1) * 16384;                                                                            \
      {                                                                                                                      \
        bf16x8 af0[4], af1[4];                                                                                               \
        const int c0 = (lane >> 4), c1 = 4 + (lane >> 4);                                                                    \
        _Pragma("unroll") for (int i = 0; i < 4; ++i) {                                                                      \
          const int ra_ = wr * 64 + i * 16 + (lane & 15);                                                                    \
          af0[i] = *(const bf16x8*)(sa + ra_ * 128 + ((c0 ^ ((ra_ >> 1) & 7)) << 4));                                        \
          af1[i] = *(const bf16x8*)(sa + ra_ * 128 + ((c1 ^ ((ra_ >> 1) & 7)) << 4));                                        \
        }                                                                                                                    \
        __builtin_amdgcn_sched_barrier(0);                                                                                   \
        _Pragma("unroll") for (int nt = 0; nt < 4; ++nt) {                                                                   \
          _Pragma("unroll") for (int mt = 0; mt < 4; ++mt)                                                                   \
            acc[nt][mt] = __builtin_amdgcn_mfma_f32_16x16x32_bf16(BC[nt], af0[mt], acc[nt][mt], 0, 0, 0);                    \
        }                                                                                                                    \
        _Pragma("unroll") for (int nt = 0; nt < 4; ++nt) {                                                                   \
          _Pragma("unroll") for (int mt = 0; mt < 4; ++mt)                                                                   \
            acc[nt][mt] = __builtin_amdgcn_mfma_f32_16x16x32_bf16(BC[4 + nt], af1[mt], acc[nt][mt], 0, 0, 0);                \
        }                                                                                                                    \
      }                                                                                                                      \
      __builtin_amdgcn_sched_barrier(0);                                                                                     \
      if (HASNEXT) GEMM_LSTORE(((kt) + 1) & 1)                                                                               \
      __syncthreads();                                                                                                       \
    }
    GEMM_GLOAD(0)
    GEMM_BLOAD(bfA, 0)
    __syncthreads();
    GEMM_LSTORE(0)
    __syncthreads();
    for (int k2 = 0; k2 < 8; ++k2) {
      GEMM_KSTEP(2 * k2, bfA, bfB, true)
      GEMM_KSTEP(2 * k2 + 1, bfB, bfA, (k2 < 7))
    }
    if (EPI == 2) {
      char* QL = smem;
      char* KL = smem + 32768;
#pragma unroll
      for (int nt = 0; nt < 4; ++nt)
#pragma unroll
        for (int mt = 0; mt < 4; ++mt) {
          const int m_ = wr * 64 + mt * 16 + (lane & 15);
          const int n_ = wc * 64 + nt * 16 + (lane >> 4) * 4;
          uint2 pk; pk.x = pack2bf(acc[nt][mt][0], acc[nt][mt][1]); pk.y = pack2bf(acc[nt][mt][2], acc[nt][mt][3]);
          *(uint2*)(QL + m_ * 256 + (((n_ >> 3) ^ (m_ & 15)) << 4) + (n_ & 4) * 2) = pk;
        }
      {
        const bf16_t* kb = p.KEYSb + (size_t)l * 2 * 128 * 64;
        int t2 = tid;
        asm volatile("" : "+v"(t2));
#pragma unroll
        for (int i = 0; i < 8; ++i) {
          const int e = i * 256 + t2;
          const int half = e >> 10, r = (e >> 3) & 127, c = e & 7;
          *(bf16x8*)(KL + half * 16384 + ksw(r, c)) = *(const bf16x8*)(kb + (size_t)(half * 128 + r) * 64 + c * 8);
        }
      }
      __syncthreads();
      topk_tile(p, QL, KL, (unsigned char*)(smem + 65536) + w * 1024, bm, bn >> 7, lane, w);
      __syncthreads();
    } else {
    float* ST = (float*)smem;
#pragma unroll
    for (int hseg = 0; hseg < 2; ++hseg) {
      if (wr == hseg) {
#pragma unroll
        for (int nt = 0; nt < 4; ++nt)
#pragma unroll
          for (int mt = 0; mt < 4; ++mt)
            *(float4*)&ST[(mt * 16 + (lane & 15)) * 132 + wc * 64 + nt * 16 + (lane >> 4) * 4] =
                make_float4(acc[nt][mt][0], acc[nt][mt][1], acc[nt][mt][2], acc[nt][mt][3]);
      }
      __syncthreads();
#pragma unroll
      for (int i = 0; i < 4; ++i) {
        const int e = i * 256 + tid;
        const int row = e >> 4, cc = (e & 15) * 8;
        const int m = bm + hseg * 64 + row, n = bn + cc;
        float4 v0 = *(const float4*)&ST[row * 132 + cc], v1 = *(const float4*)&ST[row * 132 + cc + 4];
        if (EPI == 0) {
          *(uint4*)&Cb[(size_t)m * N + n] = make_uint4(pack2bf(v0.x, v0.y), pack2bf(v0.z, v0.w), pack2bf(v1.x, v1.y), pack2bf(v1.z, v1.w));
          if (m < TCTX && n >= C_KA && n < C_UB) {
            size_t oo = ((size_t)((m >> 8) * DEPTH + l) * 256 + (m & 255)) * 256;
            float* dst = n < C_VA ? &p.out[O_NK + oo + (n - C_KA)] : &p.out[O_NV + oo + (n - C_VA)];
            *(float4*)dst = v0; *(float4*)(dst + 4) = v1;
          }
        } else if (EPI == 1) {
          const float* g1 = p.MOD + ((size_t)l * NCOND + cond_of(m)) * 6144 + 2048 + n;
          float xv[8];
          if (l == 0) {
            const float* xr = m < TCTX ? p.in.x_prompt + (size_t)m * D : p.in.x_sample + (size_t)(m - TCTX) * D;
            ld8(xr + n, xv);
          } else {
            ld8b(p.Xb + (size_t)m * D + n, xv);
          }
          float4 ga = *(const float4*)g1, gb = *(const float4*)(g1 + 4);
          *(uint4*)&p.MIXb[(size_t)m * N + n] = make_uint4(
              pack2bf(ALPHA * xv[0] + ga.x * v0.x, ALPHA * xv[1] + ga.y * v0.y), pack2bf(ALPHA * xv[2] + ga.z * v0.z, ALPHA * xv[3] + ga.w * v0.w),
              pack2bf(ALPHA * xv[4] + gb.x * v1.x, ALPHA * xv[5] + gb.y * v1.y), pack2bf(ALPHA * xv[6] + gb.z * v1.z, ALPHA * xv[7] + gb.w * v1.w));
        } else {
          *(uint4*)&Cb[(size_t)m * N + n] = make_uint4(pack2bf(v0.x, v0.y), pack2bf(v0.z, v0.w), pack2bf(v1.x, v1.y), pack2bf(v1.z, v1.w));
        }
      }
      __syncthreads();
    }
    }
  }
}

using s16x4 = __attribute__((ext_vector_type(4))) short;
__device__ __forceinline__ bf16x8 pack8(const float* v) {
  bf16x8 o;
#pragma unroll
  for (int j = 0; j < 8; ++j) o[j] = (short)f2bf(v[j]);
  return o;
}
__device__ __forceinline__ void ks_write(char* KS, int tid, const float* v) {
  int row = tid >> 2, cp = tid & 3;
  *(bf16x8*)(KS + ksw(row, cp * 2)) = pack8(v);
  *(bf16x8*)(KS + ksw(row, cp * 2 + 1)) = pack8(v + 8);
}
constexpr int VTS = 68;
__device__ __forceinline__ void vt_write(bf16_t* VT, int tid, const float* v) {
  int row = tid & 63, cc = (tid >> 6) * 16;
#pragma unroll
  for (int i = 0; i < 16; ++i) VT[(cc + i) * VTS + row] = f2bf(v[i]);
}
__device__ __forceinline__ bf16x8 vt_frag_perm(const bf16_t* VT, int r, int ks, int g) {
  s16x4 lo = *(const s16x4*)(VT + r * VTS + 32 * ks + 4 * g);
  s16x4 hi = *(const s16x4*)(VT + r * VTS + 32 * ks + 16 + 4 * g);
  return __builtin_shufflevector(lo, hi, 0, 1, 2, 3, 4, 5, 6, 7);
}
__device__ __forceinline__ bf16x8 vt_frag_nat(const bf16_t* VT, int r, int ks, int g) {
  s16x4 lo = *(const s16x4*)(VT + r * VTS + 32 * ks + 8 * g);
  s16x4 hi = *(const s16x4*)(VT + r * VTS + 32 * ks + 8 * g + 4);
  return __builtin_shufflevector(lo, hi, 0, 1, 2, 3, 4, 5, 6, 7);
}
__device__ __forceinline__ bf16x8 pack_pt(const f32x4& a, const f32x4& b) {
  bf16x8 o;
  o[0] = (short)f2bf(a[0]); o[1] = (short)f2bf(a[1]); o[2] = (short)f2bf(a[2]); o[3] = (short)f2bf(a[3]);
  o[4] = (short)f2bf(b[0]); o[5] = (short)f2bf(b[1]); o[6] = (short)f2bf(b[2]); o[7] = (short)f2bf(b[3]);
  return o;
}
#define MFMA16(a, b, c) __builtin_amdgcn_mfma_f32_16x16x32_bf16((a), (b), (c), 0, 0, 0)
#define EXP2(x) __builtin_amdgcn_exp2f(x)

__device__ void attn_phase(const P& p, int l, char* smem, const int g_wbase) {
  const In& in = p.in;
  const bf16_t* Z = p.Z;
  char* KS0 = smem;
  bf16_t* VT0 = (bf16_t*)(smem + 16384);
  const int tid = otid(g_wbase), lane = tid & 63, w = tid >> 6, g = lane >> 4, li = lane & 15;
  const float* lp = in.diff_lambda + l * 128;
  float s01 = 0.f, s23 = 0.f;
  for (int i = 0; i < 32; ++i) { s01 += lp[i] * lp[32 + i]; s23 += lp[64 + i] * lp[96 + i]; }
  const float lmi = lam_init(l);
  const float lam = expf(s01) - expf(s23) + lmi;
  const float QSCALE = 0.17677669529663687f * 1.4426950408889634f;
  FOR_VB(512) {
    const bool lat = vb < 256;
    int seq, h, qb;
    if (lat) {
      const int grp = (vb & 7) * 4 + (vb >> 6), q8 = (vb >> 3) & 7;
      seq = grp >> 2; h = grp & 3; qb = q8;
    }
    else { int r = vb - 256; seq = r >> 3; h = (r >> 1) & 3; qb = r & 1; }
    const int tbase = lat ? TCTX + seq * 1024 : seq * 256;
    const int nkeys = lat ? 1536 : 256;
    bf16x8 qf[2][2];
#pragma unroll
    for (int c = 0; c < 2; ++c) {
      const int n = qb * 128 + w * 32 + c * 16 + li;
      const bf16_t* qrow = Z + (size_t)(tbase + n) * INW + C_QA + h * 64;
#pragma unroll
      for (int pp = 0; pp < 2; ++pp) {
        float x[8];
        ld8b(qrow + pp * 32 + 8 * g, x);
        if (lat) {
          float y[8];
          ld8b(qrow + pp * 32 + 8 * (g ^ 1), y);
          const int pos = (g < 2) ? (n >> 6) : (n & 63);
          const bool first = !(g & 1);
#pragma unroll
          for (int j = 0; j < 8; ++j) {
            float2 cs = p.ROPE[pos * 8 + j];
            x[j] = first ? x[j] * cs.x - y[j] * cs.y : x[j] * cs.x + y[j] * cs.y;
          }
        }
#pragma unroll
        for (int j = 0; j < 8; ++j) x[j] *= QSCALE;
        qf[pp][c] = pack8(x);
      }
    }
    uint4 rk0, rk1, rv0, rv1, sk0, sk1, sv0, sv1;
#define ATT_FETCH_K(kt0, rk0, rk1)                                                                 \
    {                                                                                    \
      const int j_ = (kt0) + (tid >> 2), cp_ = tid & 3;                                  \
      const bf16_t* s_;                                                                  \
      if (!lat) s_ = Z + (size_t)(tbase + j_) * INW + C_KA + h * 64 + cp_ * 16;          \
      else if ((kt0) < 512) s_ = p.CKb + ((size_t)((seq * DEPTH + l) * 512 + j_) * 4 + h) * 64 + cp_ * 16; \
      else s_ = Z + (size_t)(tbase + j_ - 512) * INW + C_KA + h * 64 + cp_ * 16;         \
      rk0 = *(const uint4*)s_; rk1 = *(const uint4*)(s_ + 8);                            \
    }
#define ATT_FETCH_V(kt0, rv0, rv1)                                                                 \
    {                                                                                    \
      const int j_ = (kt0) + (tid & 63), cc_ = (tid >> 6) * 16;                          \
      const bf16_t* s_;                                                                  \
      if (!lat) s_ = Z + (size_t)(tbase + j_) * INW + C_VA + h * 64 + cc_;               \
      else if ((kt0) < 512) s_ = p.CVb + ((size_t)((seq * DEPTH + l) * 512 + j_) * 4 + h) * 64 + cc_; \
      else s_ = Z + (size_t)(tbase + j_ - 512) * INW + C_VA + h * 64 + cc_;              \
      rv0 = *(const uint4*)s_; rv1 = *(const uint4*)(s_ + 8);                            \
    }
#define UNPK16(R0, R1, V)                                                                \
    V[0] = bflo(R0.x); V[1] = bfhi(R0.x); V[2] = bflo(R0.y); V[3] = bfhi(R0.y); V[4] = bflo(R0.z); V[5] = bfhi(R0.z); V[6] = bflo(R0.w); V[7] = bfhi(R0.w); \
    V[8] = bflo(R1.x); V[9] = bfhi(R1.x); V[10] = bflo(R1.y); V[11] = bfhi(R1.y); V[12] = bflo(R1.z); V[13] = bfhi(R1.z); V[14] = bflo(R1.w); V[15] = bfhi(R1.w);
#define ATT_COMMIT_K(kt0, rk0, rk1, KS)                                                                \
    {                                                                                    \
      if (lat && (kt0) >= 512) {                                                         \
        float v_[16];                                                                    \
        UNPK16(rk0, rk1, v_)                                                             \
        const int n_ = (kt0) + (tid >> 2) - 512;                                         \
        const int pos_ = (tid & 1) ? (n_ & 63) : (n_ >> 6);                              \
        _Pragma("unroll") for (int i_ = 0; i_ < 8; ++i_) {                               \
          float2 cs_ = p.ROPE[pos_ * 8 + i_];                                            \
          float x1_ = v_[i_], x2_ = v_[8 + i_];                                          \
          v_[i_] = x1_ * cs_.x - x2_ * cs_.y;                                            \
          v_[8 + i_] = x2_ * cs_.x + x1_ * cs_.y;                                        \
        }                                                                                \
        ks_write(KS, tid, v_);                                                           \
      } else {                                                                           \
        const int row_ = tid >> 2, cp_ = tid & 3;                                        \
        *(uint4*)(KS + ksw(row_, cp_ * 2)) = rk0;                                        \
        *(uint4*)(KS + ksw(row_, cp_ * 2 + 1)) = rk1;                                    \
      }                                                                                  \
    }
#define ATT_COMMIT_V(rv0, rv1, VT)                                                                   \
    {                                                                                    \
      const int row_ = tid & 63, cc_ = (tid >> 6) * 16;                                  \
      const unsigned w_[8] = {rv0.x, rv0.y, rv0.z, rv0.w, rv1.x, rv1.y, rv1.z, rv1.w};   \
      _Pragma("unroll") for (int i_ = 0; i_ < 8; ++i_) {                                 \
        VT[(cc_ + 2 * i_) * VTS + row_] = (bf16_t)(w_[i_] & 0xffffu);                    \
        VT[(cc_ + 2 * i_ + 1) * VTS + row_] = (bf16_t)(w_[i_] >> 16);                    \
      }                                                                                  \
    }
    float mx[2][2], ls[2][2];
#pragma unroll
    for (int a = 0; a < 2; ++a)
#pragma unroll
      for (int b = 0; b < 2; ++b) { mx[a][b] = -1e30f; ls[a][b] = 0.f; }
    ATT_FETCH_K(0, rk0, rk1)
    ATT_FETCH_K(64, sk0, sk1)
    for (int kt0 = 0; kt0 < nkeys; kt0 += 128) {
      __syncthreads();
      ATT_COMMIT_K(kt0, rk0, rk1, KS0)
      ATT_COMMIT_K(kt0 + 64, sk0, sk1, (KS0 + 8192))
      __syncthreads();
      if (kt0 + 128 < nkeys) { ATT_FETCH_K(kt0 + 128, rk0, rk1) ATT_FETCH_K(kt0 + 192, sk0, sk1) }
#pragma unroll
      for (int hk = 0; hk < 2; ++hk) {
      const char* KS = KS0 + hk * 8192;
#pragma unroll
      for (int pp = 0; pp < 2; ++pp) {
        f32x4 st[4][2];
#pragma unroll
        for (int kt = 0; kt < 4; ++kt) {
          bf16x8 kf = *(const bf16x8*)(KS + ksw(kt * 16 + li, pp * 4 + g));
#pragma unroll
          for (int c = 0; c < 2; ++c) st[kt][c] = MFMA16(kf, qf[pp][c], (f32x4{0.f, 0.f, 0.f, 0.f}));
        }
#pragma unroll
        for (int c = 0; c < 2; ++c) {
          float tm = st[0][c][0];
#pragma unroll
          for (int kt = 0; kt < 4; ++kt)
#pragma unroll
            for (int r = 0; r < 4; ++r) tm = fmaxf(tm, st[kt][c][r]);
          float mn = fmaxf(mx[pp][c], tm);
          float acc = ls[pp][c] * EXP2(mx[pp][c] - mn);
#pragma unroll
          for (int kt = 0; kt < 4; ++kt)
#pragma unroll
            for (int r = 0; r < 4; ++r) acc += EXP2(st[kt][c][r] - mn);
          ls[pp][c] = acc; mx[pp][c] = mn;
        }
      }
      }
    }
    float il[2][2];
#pragma unroll
    for (int pp = 0; pp < 2; ++pp)
#pragma unroll
      for (int c = 0; c < 2; ++c) {
        float m0 = mx[pp][c], l0 = ls[pp][c];
#pragma unroll
        for (int off = 16; off <= 32; off <<= 1) {
          float mo = __shfl_xor(m0, off), lo = __shfl_xor(l0, off);
          float M = fmaxf(m0, mo);
          l0 = l0 * EXP2(m0 - M) + lo * EXP2(mo - M);
          m0 = M;
        }
        mx[pp][c] = m0; il[pp][c] = 1.f / l0;
      }
    f32x4 o[4][2];
#pragma unroll
    for (int dt = 0; dt < 4; ++dt)
#pragma unroll
      for (int c = 0; c < 2; ++c) o[dt][c] = f32x4{0.f, 0.f, 0.f, 0.f};
    ATT_FETCH_K(0, rk0, rk1)
    ATT_FETCH_V(0, rv0, rv1)
    ATT_FETCH_K(64, sk0, sk1)
    ATT_FETCH_V(64, sv0, sv1)
    for (int kt0 = 0; kt0 < nkeys; kt0 += 128) {
      __syncthreads();
      ATT_COMMIT_K(kt0, rk0, rk1, KS0)
      ATT_COMMIT_V(rv0, rv1, VT0)
      ATT_COMMIT_K(kt0 + 64, sk0, sk1, (KS0 + 8192))
      ATT_COMMIT_V(sv0, sv1, (VT0 + 64 * VTS))
      __syncthreads();
      if (kt0 + 128 < nkeys) { ATT_FETCH_K(kt0 + 128, rk0, rk1) ATT_FETCH_V(kt0 + 128, rv0, rv1) ATT_FETCH_K(kt0 + 192, sk0, sk1) ATT_FETCH_V(kt0 + 192, sv0, sv1) }
#pragma unroll
      for (int hk = 0; hk < 2; ++hk) {
      const char* KS = KS0 + hk * 8192;
      const bf16_t* VT = VT0 + hk * 64 * VTS;
      f32x4 pt[4][2];
#pragma unroll
      for (int kt = 0; kt < 4; ++kt) {
        bf16x8 k1 = *(const bf16x8*)(KS + ksw(kt * 16 + li, g));
        bf16x8 k2 = *(const bf16x8*)(KS + ksw(kt * 16 + li, 4 + g));
#pragma unroll
        for (int c = 0; c < 2; ++c) {
          f32x4 s1 = MFMA16(k1, qf[0][c], (f32x4{0.f, 0.f, 0.f, 0.f}));
          f32x4 s2 = MFMA16(k2, qf[1][c], (f32x4{0.f, 0.f, 0.f, 0.f}));
#pragma unroll
          for (int r = 0; r < 4; ++r)
            pt[kt][c][r] = EXP2(s1[r] - mx[0][c]) * il[0][c] - lam * (EXP2(s2[r] - mx[1][c]) * il[1][c]);
        }
      }
#pragma unroll
      for (int ks = 0; ks < 2; ++ks) {
        bf16x8 pb[2];
#pragma unroll
        for (int c = 0; c < 2; ++c) pb[c] = pack_pt(pt[2 * ks][c], pt[2 * ks + 1][c]);
#pragma unroll
        for (int dt = 0; dt < 4; ++dt) {
          bf16x8 vf = vt_frag_perm(VT, dt * 16 + li, ks, g);
#pragma unroll
          for (int c = 0; c < 2; ++c) o[dt][c] = MFMA16(vf, pb[c], o[dt][c]);
        }
      }
      }
    }
#pragma unroll
    for (int c = 0; c < 2; ++c) {
      float ss = 0.f;
#pragma unroll
      for (int dt = 0; dt < 4; ++dt)
#pragma unroll
        for (int r = 0; r < 4; ++r) ss += o[dt][c][r] * o[dt][c][r];
      ss += __shfl_xor(ss, 16);
      ss += __shfl_xor(ss, 32);
      const float rr = rsqrtf(ss * (1.f / 64.f) + LN_EPS) * (1.f - lmi);
      const int n = qb * 128 + w * 32 + c * 16 + li;
#pragma unroll
      for (int dt = 0; dt < 4; ++dt) {
        const int dv = dt * 16 + 4 * g;
        const float* gg = in.diff_subln_g + l * 64 + dv;
        uint2 pk;
        pk.x = pack2bf(o[dt][c][0] * rr * gg[0], o[dt][c][1] * rr * gg[1]);
        pk.y = pack2bf(o[dt][c][2] * rr * gg[2], o[dt][c][3] * rr * gg[3]);
        *(uint2*)&p.MIXCATb[(size_t)(tbase + n) * D + h * 64 + dv] = pk;
      }
    }
  }
}

__device__ void ret_phase(const P& p, int l, char* smem, const int g_wbase) {
  const In& in = p.in;
  const bf16_t* Z = p.Z;
  char* KS = smem;
  bf16_t* VT = (bf16_t*)(smem + 8192);
  bf16_t* VT2 = (bf16_t*)(smem + 8192 + 8704);
  const int tid = otid(g_wbase), lane = tid & 63, w = tid >> 6, g = lane >> 4, li = lane & 15;
  FOR_VB(512) {
    const int it = (vb + 256) & 511;
    const bool lat = it < 256;
    int seq, h, qb;
    if (lat) { const int grp = (it & 7) * 4 + (it >> 6), q8 = (it >> 3) & 7; seq = grp >> 2; h = grp & 3; qb = q8; }
    else { int r = it - 256; seq = r >> 3; h = (r >> 1) & 3; qb = r & 1; }
    const int tbase = lat ? TCTX + seq * 1024 : seq * 256;
    const int nlen = lat ? 1024 : 256;
    const float lgf = -log1pf(expf(-in.ret_decay[(l * 2 + 0) * 4 + h])) * 1.4426950408889634f;
    const float lgb = -log1pf(expf(-in.ret_decay[(l * 2 + 1) * 4 + h])) * 1.4426950408889634f;
    bf16x8 qf[2][2];
#pragma unroll
    for (int c = 0; c < 2; ++c) {
      const int n = qb * 128 + w * 32 + c * 16 + li;
      const bf16_t* qrow = Z + (size_t)(tbase + n) * INW + C_QC + h * 64;
#pragma unroll
      for (int ks = 0; ks < 2; ++ks) {
        float x[8];
        ld8b(qrow + ks * 32 + 8 * g, x);
        qf[ks][c] = pack8(x);
      }
    }
    f32x4 o[4][2];
#pragma unroll
    for (int dt = 0; dt < 4; ++dt)
#pragma unroll
      for (int c = 0; c < 2; ++c) o[dt][c] = f32x4{0.f, 0.f, 0.f, 0.f};
    if (lat) {
      __syncthreads();
      {
        const float* s0f = in.state_ret + ((size_t)((seq * DEPTH + l) * 2 + 0) * 4 + h) * 4096;
        const float* s0b = in.state_ret + ((size_t)((seq * DEPTH + l) * 2 + 1) * 4 + h) * 4096;
        float v[16];
        ld16(s0f + (tid & 63) * 64 + (tid >> 6) * 16, v);
        vt_write(VT, tid, v);
        ld16(s0b + (tid & 63) * 64 + (tid >> 6) * 16, v);
        vt_write(VT2, tid, v);
      }
      __syncthreads();
#pragma unroll
      for (int dir = 0; dir < 2; ++dir) {
        const bf16_t* ST = dir ? VT2 : VT;
        f32x4 tmp[4][2];
#pragma unroll
        for (int dt = 0; dt < 4; ++dt)
#pragma unroll
          for (int c = 0; c < 2; ++c) tmp[dt][c] = f32x4{0.f, 0.f, 0.f, 0.f};
#pragma unroll
        for (int ks = 0; ks < 2; ++ks)
#pragma unroll
          for (int dt = 0; dt < 4; ++dt) {
            bf16x8 af = vt_frag_nat(ST, dt * 16 + li, ks, g);
#pragma unroll
            for (int c = 0; c < 2; ++c) tmp[dt][c] = MFMA16(af, qf[ks][c], tmp[dt][c]);
          }
#pragma unroll
        for (int c = 0; c < 2; ++c) {
          const int n = qb * 128 + w * 32 + c * 16 + li;
          const float sc = dir ? EXP2(lgb * (float)(nlen - n)) : EXP2(lgf * (float)(n + 1));
#pragma unroll
          for (int dt = 0; dt < 4; ++dt)
#pragma unroll
            for (int r = 0; r < 4; ++r) o[dt][c][r] += sc * tmp[dt][c][r];
        }
      }
    }
    uint4 rk0, rk1, rv0, rv1;
#define RET_FETCH(kt0)                                                                   \
    {                                                                                    \
      const bf16_t* sk_ = Z + (size_t)(tbase + (kt0) + (tid >> 2)) * INW + C_KC + h * 64 + (tid & 3) * 16; \
      const bf16_t* sv_ = Z + (size_t)(tbase + (kt0) + (tid & 63)) * INW + C_VC + h * 64 + (tid >> 6) * 16; \
      rk0 = *(const uint4*)sk_; rk1 = *(const uint4*)(sk_ + 8);                          \
      rv0 = *(const uint4*)sv_; rv1 = *(const uint4*)(sv_ + 8);                          \
    }
    RET_FETCH(0)
    for (int kt0 = 0; kt0 < nlen; kt0 += 64) {
      __syncthreads();
      {
        const int row_ = tid >> 2, cp_ = tid & 3;
        *(uint4*)(KS + ksw(row_, cp_ * 2)) = rk0;
        *(uint4*)(KS + ksw(row_, cp_ * 2 + 1)) = rk1;
        const int vrow_ = tid & 63, cc_ = (tid >> 6) * 16;
        const unsigned w_[8] = {rv0.x, rv0.y, rv0.z, rv0.w, rv1.x, rv1.y, rv1.z, rv1.w};
#pragma unroll
        for (int i_ = 0; i_ < 8; ++i_) {
          VT[(cc_ + 2 * i_) * VTS + vrow_] = (bf16_t)(w_[i_] & 0xffffu);
          VT[(cc_ + 2 * i_ + 1) * VTS + vrow_] = (bf16_t)(w_[i_] >> 16);
        }
      }
      __syncthreads();
      if (kt0 + 64 < nlen) RET_FETCH(kt0 + 64)
      f32x4 pt[4][2];
#pragma unroll
      for (int kt = 0; kt < 4; ++kt) {
        bf16x8 k1 = *(const bf16x8*)(KS + ksw(kt * 16 + li, g));
        bf16x8 k2 = *(const bf16x8*)(KS + ksw(kt * 16 + li, 4 + g));
#pragma unroll
        for (int c = 0; c < 2; ++c) {
          f32x4 s = MFMA16(k1, qf[0][c], (f32x4{0.f, 0.f, 0.f, 0.f}));
          s = MFMA16(k2, qf[1][c], s);
          const int tq = qb * 128 + w * 32 + c * 16 + li;
#pragma unroll
          for (int r = 0; r < 4; ++r) {
            const int sk = kt0 + kt * 16 + 4 * g + r;
            const int rel = tq - sk;
            float dec = rel > 0 ? EXP2(lgf * (float)rel) : (rel < 0 ? EXP2(lgb * (float)(-rel)) : 2.f);
            pt[kt][c][r] = s[r] * dec * 0.125f;
          }
        }
      }
#pragma unroll
      for (int ks = 0; ks < 2; ++ks) {
        bf16x8 pb[2];
#pragma unroll
        for (int c = 0; c < 2; ++c) pb[c] = pack_pt(pt[2 * ks][c], pt[2 * ks + 1][c]);
#pragma unroll
        for (int dt = 0; dt < 4; ++dt) {
          bf16x8 vf = vt_frag_perm(VT, dt * 16 + li, ks, g);
#pragma unroll
          for (int c = 0; c < 2; ++c) o[dt][c] = MFMA16(vf, pb[c], o[dt][c]);
        }
      }
    }
#pragma unroll
    for (int c = 0; c < 2; ++c) {
      float s = 0.f;
#pragma unroll
      for (int dt = 0; dt < 4; ++dt)
#pragma unroll
        for (int r = 0; r < 4; ++r) s += o[dt][c][r];
      s += __shfl_xor(s, 16);
      s += __shfl_xor(s, 32);
      const float mu = s * (1.f / 64.f);
      float sq = 0.f;
#pragma unroll
      for (int dt = 0; dt < 4; ++dt)
#pragma unroll
        for (int r = 0; r < 4; ++r) { float d = o[dt][c][r] - mu; sq += d * d; }
      sq += __shfl_xor(sq, 16);
      sq += __shfl_xor(sq, 32);
      const float rr = rsqrtf(sq * (1.f / 64.f) + LN_EPS);
      const int n = qb * 128 + w * 32 + c * 16 + li;
#pragma unroll
      for (int dt = 0; dt < 4; ++dt) {
        const int dv = dt * 16 + 4 * g;
        uint2 gq = *(const uint2*)&Z[(size_t)(tbase + n) * INW + C_GC + h * 64 + dv];
        uint2 pk;
        pk.x = pack2bf((o[dt][c][0] - mu) * rr * silu_f(bflo(gq.x)), (o[dt][c][1] - mu) * rr * silu_f(bfhi(gq.x)));
        pk.y = pack2bf((o[dt][c][2] - mu) * rr * silu_f(bflo(gq.y)), (o[dt][c][3] - mu) * rr * silu_f(bfhi(gq.y)));
        *(uint2*)&p.MIXCATb[(size_t)(tbase + n) * D + 512 + h * 64 + dv] = pk;
      }
    }
  }
}

__device__ void ret_state_phase(const P& p, int l, char* smem, const int g_wbase) {
  const In& in = p.in;
  const bf16_t* Z = p.Z;
  bf16_t* KTF = (bf16_t*)smem;
  bf16_t* KTB = (bf16_t*)(smem + 8704);
  bf16_t* VT = (bf16_t*)(smem + 2 * 8704);
  const int tid = otid(g_wbase), lane = tid & 63, w = tid >> 6, g = lane >> 4, li = lane & 15;
  FOR_VB(128) {
    const int seq = vb >> 2, h = vb & 3;
    const int tbase = seq * 256;
    const float lgf = -log1pf(expf(-in.ret_decay[(l * 2 + 0) * 4 + h])) * 1.4426950408889634f;
    const float lgb = -log1pf(expf(-in.ret_decay[(l * 2 + 1) * 4 + h])) * 1.4426950408889634f;
    f32x4 af[4], ab[4];
#pragma unroll
    for (int vt = 0; vt < 4; ++vt) { af[vt] = f32x4{0.f, 0.f, 0.f, 0.f}; ab[vt] = f32x4{0.f, 0.f, 0.f, 0.f}; }
    for (int kt0 = 0; kt0 < 256; kt0 += 64) {
      __syncthreads();
      {
        const int s = kt0 + (tid & 63);
        float v[16], u[16];
        ld16b(Z + (size_t)(tbase + s) * INW + C_KC + h * 64 + (tid >> 6) * 16, v);
        const float df = EXP2(lgf * (float)(255 - s)) * 0.125f, db = EXP2(lgb * (float)s) * 0.125f;
#pragma unroll
        for (int i = 0; i < 16; ++i) u[i] = v[i] * df;
        vt_write(KTF, tid, u);
#pragma unroll
        for (int i = 0; i < 16; ++i) u[i] = v[i] * db;
        vt_write(KTB, tid, u);
        ld16b(Z + (size_t)(tbase + s) * INW + C_VC + h * 64 + (tid >> 6) * 16, v);
        vt_write(VT, tid, v);
      }
      __syncthreads();
#pragma unroll
      for (int ks = 0; ks < 2; ++ks) {
        bf16x8 kf = vt_frag_nat(KTF, w * 16 + li, ks, g);
        bf16x8 kb = vt_frag_nat(KTB, w * 16 + li, ks, g);
#pragma unroll
        for (int vt = 0; vt < 4; ++vt) {
          bf16x8 vf = vt_frag_nat(VT, vt * 16 + li, ks, g);
          af[vt] = MFMA16(kf, vf, af[vt]);
          ab[vt] = MFMA16(kb, vf, ab[vt]);
        }
      }
    }
    float* sf = p.out + O_NS + ((size_t)((seq * DEPTH + l) * 2 + 0) * 4 + h) * 4096;
    float* sb = p.out + O_NS + ((size_t)((seq * DEPTH + l) * 2 + 1) * 4 + h) * 4096;
#pragma unroll
    for (int vt = 0; vt < 4; ++vt)
#pragma unroll
      for (int r = 0; r < 4; ++r) {
        const int d = w * 16 + 4 * g + r, v = vt * 16 + li;
        sf[d * 64 + v] = af[vt][r];
        sb[d * 64 + v] = ab[vt][r];
      }
  }
}


__device__ void cacheconv_phase(const P& p) {
  const size_t n8 = (size_t)8 * DEPTH * 512 * 256 / 8;
  for (size_t i = (size_t)blockIdx.x * 256 + threadIdx.x; i < 2 * n8; i += (size_t)gridDim.x * 256) {
    const float* s = i < n8 ? p.in.cache_k + i * 8 : p.in.cache_v + (i - n8) * 8;
    bf16_t* d = i < n8 ? p.CKb + i * 8 : p.CVb + (i - n8) * 8;
    float4 a = *(const float4*)s, b = *(const float4*)(s + 4);
    *(uint4*)d = make_uint4(pack2bf(a.x, a.y), pack2bf(a.z, a.w), pack2bf(b.x, b.y), pack2bf(b.z, b.w));
  }
}
__device__ void keysconv_phase(const P& p) {
  for (int i = blockIdx.x * 256 + threadIdx.x; i < DEPTH * 2 * 128 * 64; i += gridDim.x * 256) p.KEYSb[i] = f2bf(p.in.peer_keys[i]);
}

__device__ void gmlp_phase(const P& p, int l, char* smem, const int g_wbase) {
  const In& in = p.in;
  const bf16_t* Z = p.Z;
  char* WS = smem;
  bf16_t* VT = (bf16_t*)(smem + 32768);
  constexpr int VS = 136;
  const int tid = otid(g_wbase), lane = tid & 63, w = tid >> 6, g4 = lane >> 4, li = lane & 15;
  FOR_VB(512) {
    const int chunk = vb >> 2, g = vb & 3;
    const int t0 = chunk * 128;
    __syncthreads();
    {
      const float* ws = in.gmlp_ws + (size_t)(l * 4 + g) * 128 * 128;
#pragma unroll
      for (int i = 0; i < 8; ++i) {
        int e = i * 256 + tid;
        int row = e >> 4, c = e & 15;
        float v[8];
        ld8(ws + row * 128 + c * 8, v);
        *(bf16x8*)(WS + row * 256 + ((c ^ (row & 15)) << 4)) = pack8(v);
      }
    }
    {
      const int q = tid >> 1, half = tid & 1;
      const bf16_t* zr = Z + (size_t)(t0 + q) * INW + C_VB;
      float s = 0.f, sq = 0.f;
#pragma unroll 2
      for (int i = 0; i < 16; ++i) {
        float x[8];
        ld8b(zr + half * 128 + i * 8, x);
#pragma unroll
        for (int j = 0; j < 8; ++j) { float a = gelu_f(x[j]); s += a; sq += a * a; }
      }
      s += __shfl_xor(s, 1);
      sq += __shfl_xor(sq, 1);
      const float mu = s * (1.f / 256.f);
      const float var = fmaxf(sq * (1.f / 256.f) - mu * mu, 0.f);
      const float rr = rsqrtf(var + LN_EPS);
      const float* lg = in.gmlp_ln_g + l * 256 + g * 64 + half * 32;
      const float* lb = in.gmlp_ln_b + l * 256 + g * 64 + half * 32;
#pragma unroll 2
      for (int i = 0; i < 4; ++i) {
        float x[8];
        ld8b(zr + g * 64 + half * 32 + i * 8, x);
#pragma unroll
        for (int j = 0; j < 8; ++j)
          VT[(half * 32 + i * 8 + j) * VS + q] = f2bf((gelu_f(x[j]) - mu) * rr * lg[i * 8 + j] + lb[i * 8 + j]);
      }
    }
    __syncthreads();
    f32x4 acc[4][2];
#pragma unroll
    for (int dt = 0; dt < 4; ++dt)
#pragma unroll
      for (int pt = 0; pt < 2; ++pt) acc[dt][pt] = f32x4{0.f, 0.f, 0.f, 0.f};
#pragma unroll
    for (int ks = 0; ks < 4; ++ks) {
      bf16x8 bw[2];
#pragma unroll
      for (int pt = 0; pt < 2; ++pt) {
        int row = w * 32 + pt * 16 + li, c = ks * 4 + g4;
        bw[pt] = *(const bf16x8*)(WS + row * 256 + ((c ^ (row & 15)) << 4));
      }
#pragma unroll
      for (int dt = 0; dt < 4; ++dt) {
        const bf16_t* vr = VT + (dt * 16 + li) * VS + ks * 32 + g4 * 8;
        s16x4 lo = *(const s16x4*)vr, hi = *(const s16x4*)(vr + 4);
        bf16x8 av = __builtin_shufflevector(lo, hi, 0, 1, 2, 3, 4, 5, 6, 7);
#pragma unroll
        for (int pt = 0; pt < 2; ++pt) acc[dt][pt] = MFMA16(av, bw[pt], acc[dt][pt]);
      }
    }
#pragma unroll
    for (int pt = 0; pt < 2; ++pt) {
      const int pp = w * 32 + pt * 16 + li;
      const float bs = in.gmlp_bs[(l * 4 + g) * 128 + pp];
      const bf16_t* zr = Z + (size_t)(t0 + pp) * INW + C_UB + g * 64;
#pragma unroll
      for (int dt = 0; dt < 4; ++dt) {
        const int d = dt * 16 + 4 * g4;
        uint2 uq = *(const uint2*)(zr + d);
        uint2 pk;
        pk.x = pack2bf(gelu_f(bflo(uq.x)) * (acc[dt][pt][0] + bs), gelu_f(bfhi(uq.x)) * (acc[dt][pt][1] + bs));
        pk.y = pack2bf(gelu_f(bflo(uq.y)) * (acc[dt][pt][2] + bs), gelu_f(bfhi(uq.y)) * (acc[dt][pt][3] + bs));
        *(uint2*)&p.MIXCATb[(size_t)(t0 + pp) * D + 256 + g * 64 + d] = pk;
      }
    }
  }
}

__device__ void conv_fast_phase(const P& p, int l, char* smem, const int g_wbase) {
  const In& in = p.in;
  const bf16_t* Z = p.Z;
  float* Y = (float*)smem;
  const int tid = otid(g_wbase), lane = tid & 63, w = tid >> 6;
  const int ch = tid;
  float wgt[31];
#pragma unroll
  for (int j = 0; j < 31; ++j) wgt[j] = in.conv_w[((size_t)l * 31 + j) * 256 + ch];
  const float bias = in.conv_b[l * 256 + ch];
  FOR_VB(512) {
    const bool lat = vb >= 256;
    int seq, tile, len, tbase;
    if (!lat) { seq = vb >> 3; tile = vb & 7; len = 256; tbase = seq * 256; }
    else { int r = vb - 256; seq = r >> 5; tile = r & 31; len = 1024; tbase = TCTX + seq * 1024; }
    const int n0 = tile * 32;
    float acc[32];
#pragma unroll
    for (int n = 0; n < 32; ++n) acc[n] = bias;
#pragma unroll
    for (int r0 = 0; r0 < 64; r0 += 8) {
      bf16_t ra[8], rb[8];
#pragma unroll
      for (int k = 0; k < 8; ++k) {
        const int m = n0 - 15 + r0 + k;
        const int mc = min(max(m, 0), len - 1);
        const bf16_t* zr = Z + (size_t)(tbase + mc) * INW;
        ra[k] = zr[C_AD + ch]; rb[k] = zr[C_BD + ch];
      }
#pragma unroll
      for (int k = 0; k < 8; ++k) {
        const int r = r0 + k;
        if (r < 62) {
          const int m = n0 - 15 + r;
          const float hv = (m >= 0 && m < len) ? bf2f(ra[k]) * sigmoid_f(bf2f(rb[k])) : 0.f;
#pragma unroll
          for (int n = 0; n < 32; ++n) {
            const int j = r - n;
            if (j >= 0 && j < 31) acc[n] += wgt[j] * hv;
          }
        }
      }
    }
    __syncthreads();
#pragma unroll
    for (int n = 0; n < 32; ++n) Y[n * 256 + ch] = acc[n];
    __syncthreads();
#pragma unroll
    for (int i = 0; i < 8; ++i) {
      const int n = w * 8 + i;
      float4 y = *(const float4*)&Y[n * 256 + lane * 4];
      float mu = wave_sum_u((y.x + y.y) + (y.z + y.w)) * (1.f / 256.f);
      y.x -= mu; y.y -= mu; y.z -= mu; y.w -= mu;
      float rr = rsqrtf(wave_sum_u((y.x * y.x + y.y * y.y) + (y.z * y.z + y.w * y.w)) * (1.f / 256.f) + LN_EPS);
      float4 gg = *(const float4*)&in.conv_ln_g[l * 256 + lane * 4], bb = *(const float4*)&in.conv_ln_b[l * 256 + lane * 4];
      uint2 pk;
      pk.x = pack2bf(silu_f(y.x * rr * gg.x + bb.x), silu_f(y.y * rr * gg.y + bb.y));
      pk.y = pack2bf(silu_f(y.z * rr * gg.z + bb.z), silu_f(y.w * rr * gg.w + bb.w));
      *(uint2*)&p.MIXCATb[(size_t)(tbase + n0 + n) * D + 768 + lane * 4] = pk;
    }
  }
}

__device__ void mod_fast_phase(const P& p, char* smem, const int g_wbase) {
  float* SC = (float*)smem;
  float* RED = (float*)smem + 9 * 1024;
  const int tid = otid(g_wbase), lane = tid & 63, w = tid >> 6;
  __syncthreads();
  for (int i = tid; i < 9 * 1024; i += 256) {
    int c = i >> 10, k = i & 1023;
    SC[i] = silu_f(c == 0 ? p.in.c_ctx[k] : p.in.c[(size_t)(c - 1) * D + k]);
  }
  __syncthreads();
  FOR_VB(DEPTH * 96) {
    const int l = vb / 96, n = (vb % 96) * 64 + lane;
    const float* wp = p.in.w_mod + ((size_t)l * D + w * 256) * 6144 + n;
    float acc[9];
#pragma unroll
    for (int c = 0; c < 9; ++c) acc[c] = 0.f;
#pragma unroll 8
    for (int k = 0; k < 256; ++k) {
      float wv = wp[(size_t)k * 6144];
#pragma unroll
      for (int c = 0; c < 9; ++c) acc[c] += SC[c * 1024 + w * 256 + k] * wv;
    }
    __syncthreads();
#pragma unroll
    for (int c = 0; c < 9; ++c) RED[(w * 9 + c) * 64 + lane] = acc[c];
    __syncthreads();
    for (int i = tid; i < 9 * 64; i += 256) {
      int c = i >> 6, nn = i & 63;
      float s = RED[(0 * 9 + c) * 64 + nn] + RED[(1 * 9 + c) * 64 + nn] + RED[(2 * 9 + c) * 64 + nn] + RED[(3 * 9 + c) * 64 + nn];
      int ncol = (vb % 96) * 64 + nn;
      p.MOD[((size_t)l * NCOND + c) * 6144 + ncol] = s + p.in.b_mod[l * 6144 + ncol];
    }
  }
}

typedef float f32x2_t __attribute__((ext_vector_type(2)));
template <int CTRL, int ROWMASK>
__device__ __forceinline__ float dpp_max(float v) {
  int t = __builtin_amdgcn_update_dpp(__float_as_int(v), __float_as_int(v), CTRL, ROWMASK, 0xf, false);
  return fmaxf(v, __int_as_float(t));
}
__device__ __forceinline__ float wave_max_u(float v) {
  v = dpp_max<0xB1, 0xf>(v);
  v = dpp_max<0x4E, 0xf>(v);
  v = dpp_max<0x141, 0xf>(v);
  v = dpp_max<0x140, 0xf>(v);
  v = dpp_max<0x142, 0xa>(v);
  v = dpp_max<0x143, 0xc>(v);
  return __int_as_float(__builtin_amdgcn_readlane(__float_as_int(v), 63));
}
__device__ void tabconv8_phase(const P& p, const int g_wbase) {
  const int tid = otid(g_wbase), lane = tid & 63, w = tid >> 6;
  const int NR = DEPTH * 16384;
  const int stride = gridDim.x * 4;
  for (int r0 = blockIdx.x * 4 + w; r0 < 2 * NR; r0 += 2 * stride) {
    f32x4 v[2][4];
#pragma unroll
    for (int u = 0; u < 2; ++u) {
      const int r = r0 + u * stride;
      if (r < 2 * NR) {
        const bool isv = r >= NR;
        const int rr = isv ? r - NR : r;
        const float* s = (isv ? p.in.peer_v : p.in.peer_u) + (size_t)rr * D + lane * 16;
#pragma unroll
        for (int q = 0; q < 4; ++q) v[u][q] = __builtin_nontemporal_load((const f32x4*)s + q);
      }
    }
#pragma unroll
    for (int u = 0; u < 2; ++u) {
      const int r = r0 + u * stride;
      if (r < 2 * NR) {
        const bool isv = r >= NR;
        const int rr = isv ? r - NR : r;
        float m = 0.f;
#pragma unroll
        for (int q = 0; q < 4; ++q)
#pragma unroll
          for (int i = 0; i < 4; ++i) m = fmaxf(m, fabsf(v[u][q][i]));
        m = wave_max_u(m);
        const float sc = m > 0.f ? 448.f / m : 1.f;
        unsigned qq[4];
#pragma unroll
        for (int q = 0; q < 4; ++q) {
          int t = 0;
          t = __builtin_amdgcn_cvt_pk_fp8_f32(v[u][q][0] * sc, v[u][q][1] * sc, t, false);
          t = __builtin_amdgcn_cvt_pk_fp8_f32(v[u][q][2] * sc, v[u][q][3] * sc, t, true);
          qq[q] = (unsigned)t;
        }
        *(uint4*)((isv ? p.V8 : p.U8) + (size_t)rr * D + lane * 16) = make_uint4(qq[0], qq[1], qq[2], qq[3]);
        if (lane == 0) (isv ? p.VSC : p.USC)[rr] = m > 0.f ? m * (1.f / 448.f) : 1.f;
      }
    }
  }
}
__device__ __forceinline__ void fp8x16_to_f32(const uint4& q, float* o) {
  f32x2_t t;
  t = __builtin_amdgcn_cvt_pk_f32_fp8((int)q.x, false); o[0] = t[0]; o[1] = t[1];
  t = __builtin_amdgcn_cvt_pk_f32_fp8((int)q.x, true);  o[2] = t[0]; o[3] = t[1];
  t = __builtin_amdgcn_cvt_pk_f32_fp8((int)q.y, false); o[4] = t[0]; o[5] = t[1];
  t = __builtin_amdgcn_cvt_pk_f32_fp8((int)q.y, true);  o[6] = t[0]; o[7] = t[1];
  t = __builtin_amdgcn_cvt_pk_f32_fp8((int)q.z, false); o[8] = t[0]; o[9] = t[1];
  t = __builtin_amdgcn_cvt_pk_f32_fp8((int)q.z, true);  o[10] = t[0]; o[11] = t[1];
  t = __builtin_amdgcn_cvt_pk_f32_fp8((int)q.w, false); o[12] = t[0]; o[13] = t[1];
  t = __builtin_amdgcn_cvt_pk_f32_fp8((int)q.w, true);  o[14] = t[0]; o[15] = t[1];
}
typedef __bf16 bf2v __attribute__((ext_vector_type(2)));
__device__ __forceinline__ float dot16_fp8_bf16(const uint4& q, const uint4& h0, const uint4& h1) {
  float a0 = 0.f, a1 = 0.f;
#define D16STEP(QW, HA, HB)                                                                                   \
  a0 = __builtin_amdgcn_fdot2_f32_bf16(__builtin_amdgcn_cvt_scalef32_pk_bf16_fp8((QW), 1.0f, false), __builtin_bit_cast(bf2v, (HA)), a0, false); \
  a1 = __builtin_amdgcn_fdot2_f32_bf16(__builtin_amdgcn_cvt_scalef32_pk_bf16_fp8((QW), 1.0f, true), __builtin_bit_cast(bf2v, (HB)), a1, false);
  D16STEP(q.x, h0.x, h0.y) D16STEP(q.y, h0.z, h0.w) D16STEP(q.z, h1.x, h1.y) D16STEP(q.w, h1.z, h1.w)
#undef D16STEP
  return a0 + a1;
}
template <int CTRL, int BANKMASK>
__device__ __forceinline__ float dpp_mov_bank(float old, float v) {
  return __int_as_float(__builtin_amdgcn_update_dpp(__float_as_int(old), __float_as_int(v), CTRL, 0xf, BANKMASK, false));
}
__device__ __forceinline__ float reduce8_scatter(const float (&pv)[8], int lane) {
  const bool b0 = lane & 1, b1 = lane & 2, b2 = lane & 4;
  float q[4], r[2];
#pragma unroll
  for (int i = 0; i < 4; ++i) {
    const float keep = b0 ? pv[2 * i + 1] : pv[2 * i], send = b0 ? pv[2 * i] : pv[2 * i + 1];
    q[i] = keep + __int_as_float(__builtin_amdgcn_update_dpp(0, __float_as_int(send), 0xB1, 0xf, 0xf, false));
  }
#pragma unroll
  for (int i = 0; i < 2; ++i) {
    const float keep = b1 ? q[2 * i + 1] : q[2 * i], send = b1 ? q[2 * i] : q[2 * i + 1];
    r[i] = keep + __int_as_float(__builtin_amdgcn_update_dpp(0, __float_as_int(send), 0x4E, 0xf, 0xf, false));
  }
  const float keep = b2 ? r[1] : r[0], send = b2 ? r[0] : r[1];
  float recv = dpp_mov_bank<0x104, 0x5>(send, send);
  recv = dpp_mov_bank<0x114, 0xA>(recv, send);
  float s = keep + recv;
  s += __int_as_float(__builtin_amdgcn_update_dpp(0, __float_as_int(s), 0x128, 0xf, 0xf, false));
  s += __shfl_xor(s, 16);
  s += __shfl_xor(s, 32);
  return s;
}
__device__ void peer8_phase(const P& p, int l, char* smem, const int g_wbase) {
  const In& in = p.in;
  const int tid_ = otid(g_wbase);
  const int lane = tid_ & 63, w = __builtin_amdgcn_readfirstlane(tid_ >> 6);
  const unsigned char* U8 = p.U8 + (size_t)l * 16384 * D;
  const unsigned char* V8 = p.V8 + (size_t)l * 16384 * D;
  const float* USC = p.USC + (size_t)l * 16384;
  const float* VSC = p.VSC + (size_t)l * 16384;
  const float* mod_l = p.MOD + (size_t)l * NCOND * 6144;
  const float* mod_n = p.MOD + (size_t)(l + 1 < DEPTH ? l + 1 : l) * NCOND * 6144;
  const int tstride = gridDim.x * 4;
  for (int tbase = blockIdx.x * 4 + w; tbase < T; tbase += 16 * tstride) {
  int kk = 0;
  for (int t = tbase; t < T && kk < 16; t += tstride, ++kk) {
    const uint4 ha = *(const uint4*)&p.H2b[(size_t)t * D + lane * 16];
    const uint4 hb = *(const uint4*)&p.H2b[(size_t)t * D + lane * 16 + 8];
    int e_lo, e_hi;
    {
      const int e0 = p.EIDX[(size_t)t * 128 + lane], e1 = p.EIDX[(size_t)t * 128 + 64 + lane];
      const float q0 = p.GATE[(size_t)t * 128 + lane], q1 = p.GATE[(size_t)t * 128 + 64 + lane];
      const int k0 = e0 >> 9, k1 = e1 >> 9;
      int base = 0, pos0 = 0, pos1 = 0;
#pragma unroll 4
      for (int r = 0; r < 32; ++r) {
        const unsigned long long m0 = __ballot(k0 == r), m1 = __ballot(k1 == r);
        const int c0 = __popcll(m0), c1 = __popcll(m1);
        const int lt0 = __builtin_amdgcn_mbcnt_hi((unsigned)(m0 >> 32), __builtin_amdgcn_mbcnt_lo((unsigned)m0, 0u));
        const int lt1 = __builtin_amdgcn_mbcnt_hi((unsigned)(m1 >> 32), __builtin_amdgcn_mbcnt_lo((unsigned)m1, 0u));
        if (k0 == r) pos0 = base + lt0;
        if (k1 == r) pos1 = base + c0 + lt1;
        base += c0 + c1;
      }
      int* SE = (int*)(smem + w * 16384 + kk * 1024);
      float* SG = (float*)(smem + w * 16384 + kk * 1024 + 512);
      __builtin_amdgcn_wave_barrier();
      SE[pos0] = e0; SE[pos1] = e1; SG[pos0] = q0; SG[pos1] = q1;
      __builtin_amdgcn_wave_barrier();
      e_lo = SE[lane]; e_hi = SE[64 + lane];
      __builtin_amdgcn_wave_barrier();
    }
    float a_lo = 0.f, a_hi = 0.f;
    uint4 cb[8], nb[8];
#define P8_LOAD(DST, TAB, B)                                                             \
    {                                                                                    \
      const int src_ = (B) < 8 ? e_lo : e_hi;                                            \
      _Pragma("unroll") for (int k_ = 0; k_ < 8; ++k_) {                                 \
        int ei_ = __builtin_amdgcn_readlane(src_, (((B) & 7) << 3) + k_);                \
        DST[k_] = *((const uint4*)((TAB) + (size_t)ei_ * D) + lane);                     \
      }                                                                                  \
    }
#define P8_UCOMP(SRC, B)                                                                 \
    {                                                                                    \
      float pv_[8];                                                                      \
      _Pragma("unroll") for (int k = 0; k < 8; ++k) pv_[k] = dot16_fp8_bf16(SRC[k], ha, hb); \
      const float s_ = reduce8_scatter(pv_, lane);       \
      if ((B) < 8) a_lo = ((lane >> 3) == ((B) & 7)) ? s_ : a_lo; else a_hi = ((lane >> 3) == ((B) & 7)) ? s_ : a_hi; \
    }
    P8_LOAD(cb, U8, 0)
    for (int b = 0; b < 16; b += 2) {
      P8_LOAD(nb, U8, b + 1)
      __builtin_amdgcn_sched_barrier(0);
      P8_UCOMP(cb, b)
      __builtin_amdgcn_sched_barrier(0);
      if (b + 2 < 16) P8_LOAD(cb, U8, b + 2)
      __builtin_amdgcn_sched_barrier(0);
      P8_UCOMP(nb, b + 1)
      __builtin_amdgcn_sched_barrier(0);
    }
    {
      float* SG = (float*)(smem + w * 16384 + kk * 1024 + 512);
      const float w_lo = SG[lane] * gelu_f(a_lo * USC[e_lo]) * VSC[e_lo], w_hi = SG[64 + lane] * gelu_f(a_hi * USC[e_hi]) * VSC[e_hi];
      SG[lane] = w_lo; SG[64 + lane] = w_hi;
    }
  }
  __builtin_amdgcn_wave_barrier();
  kk = 0;
  for (int t = tbase; t < T && kk < 16; t += tstride, ++kk) {
    const int e_lo = ((const int*)(smem + w * 16384 + kk * 1024))[lane], e_hi = ((const int*)(smem + w * 16384 + kk * 1024))[64 + lane];
    const float w_lo = ((const float*)(smem + w * 16384 + kk * 1024 + 512))[lane], w_hi = ((const float*)(smem + w * 16384 + kk * 1024 + 512))[64 + lane];
    uint4 cb[8], nb[8];
    float f[16];
#pragma unroll
    for (int i = 0; i < 16; ++i) f[i] = 0.f;
#define P8_VCOMP(SRC, B)                                                                 \
    {                                                                                    \
      const float wsrc = (B) < 8 ? w_lo : w_hi;                                          \
      _Pragma("unroll") for (int k = 0; k < 8; ++k) {                                    \
        const float we = __int_as_float(__builtin_amdgcn_readlane(__float_as_int(wsrc), (((B) & 7) << 3) + k)); \
        float v[16];                                                                     \
        fp8x16_to_f32(SRC[k], v);                                                        \
        _Pragma("unroll") for (int i = 0; i < 16; ++i) f[i] += we * v[i];                \
      }                                                                                  \
    }
    P8_LOAD(cb, V8, 0)
    for (int b = 0; b < 16; b += 2) {
      P8_LOAD(nb, V8, b + 1)
      __builtin_amdgcn_sched_barrier(0);
      P8_VCOMP(cb, b)
      __builtin_amdgcn_sched_barrier(0);
      if (b + 2 < 16) P8_LOAD(cb, V8, b + 2)
      __builtin_amdgcn_sched_barrier(0);
      P8_VCOMP(nb, b + 1)
      __builtin_amdgcn_sched_barrier(0);
    }
    const float* m = mod_l + (size_t)cond_of(t) * 6144;
    const float* mn = mod_n + (size_t)cond_of(t) * 6144;
    const int d0 = lane * 16;
    float v[16];
    float s = 0.f;
#pragma unroll
    for (int q = 0; q < 4; ++q) {
      float4 xa = *(const float4*)&p.X1[(size_t)t * D + d0 + q * 4];
      float4 ga = *(const float4*)&m[5120 + d0 + q * 4];
      v[q * 4 + 0] = ALPHA * xa.x + ga.x * f[q * 4 + 0]; v[q * 4 + 1] = ALPHA * xa.y + ga.y * f[q * 4 + 1];
      v[q * 4 + 2] = ALPHA * xa.z + ga.z * f[q * 4 + 2]; v[q * 4 + 3] = ALPHA * xa.w + ga.w * f[q * 4 + 3];
    }
#pragma unroll
    for (int i = 0; i < 16; ++i) s += v[i];
    const float mu = wave_sum_u(s) * (1.f / 1024.f);
    float sq = 0.f;
#pragma unroll
    for (int i = 0; i < 16; ++i) { v[i] -= mu; sq += v[i] * v[i]; }
    const float r = rsqrtf(wave_sum_u(sq) * (1.f / 1024.f) + LN_EPS);
    float o[16];
#pragma unroll
    for (int q = 0; q < 4; ++q) {
      float4 gg = *(const float4*)&in.ln2_g[l * D + d0 + q * 4], bb = *(const float4*)&in.ln2_b[l * D + d0 + q * 4];
      o[q * 4 + 0] = v[q * 4 + 0] * r * gg.x + bb.x; o[q * 4 + 1] = v[q * 4 + 1] * r * gg.y + bb.y;
      o[q * 4 + 2] = v[q * 4 + 2] * r * gg.z + bb.z; o[q * 4 + 3] = v[q * 4 + 3] * r * gg.w + bb.w;
      *(float4*)&p.X[(size_t)t * D + d0 + q * 4] = make_float4(o[q * 4], o[q * 4 + 1], o[q * 4 + 2], o[q * 4 + 3]);
    }
    if (l == DEPTH - 1) {
#pragma unroll
      for (int q = 0; q < 4; ++q) *(float4*)&p.out[(size_t)t * D + d0 + q * 4] = make_float4(o[q * 4], o[q * 4 + 1], o[q * 4 + 2], o[q * 4 + 3]);
    } else {
      unsigned hq[8];
#pragma unroll
      for (int q = 0; q < 8; ++q) {
        const int d = d0 + q * 2;
        hq[q] = pack2bf(o[q * 2] * (1.f + mn[1024 + d]) + mn[d], o[q * 2 + 1] * (1.f + mn[1024 + d + 1]) + mn[d + 1]);
      }
      *(uint4*)&p.Hb[(size_t)t * D + d0] = make_uint4(hq[0], hq[1], hq[2], hq[3]);
      *(uint4*)&p.Hb[(size_t)t * D + d0 + 8] = make_uint4(hq[4], hq[5], hq[6], hq[7]);
    }
  }
  __builtin_amdgcn_wave_barrier();
  }
}

template <int UG, int VG>
__device__ void peerx_phase(const P& p, int l, char* smem, const int g_wbase) {
  const In& in = p.in;
  const int tid_ = otid(g_wbase);
  const int lane = tid_ & 63, w = __builtin_amdgcn_readfirstlane(tid_ >> 6);
  const unsigned char* U8 = p.U8 + (size_t)l * 16384 * D;
  const unsigned char* V8 = p.V8 + (size_t)l * 16384 * D;
  const float* USC = p.USC + (size_t)l * 16384;
  const float* VSC = p.VSC + (size_t)l * 16384;
  const float* mod_l = p.MOD + (size_t)l * NCOND * 6144;
  const float* mod_n = p.MOD + (size_t)(l + 1 < DEPTH ? l + 1 : l) * NCOND * 6144;
  const int tstride = gridDim.x * 4;
  char* SW = smem + w * 16384;
  for (int tbase = blockIdx.x * 4 + w; tbase < T; tbase += 16 * tstride) {
    int ntok = (T - tbase + tstride - 1) / tstride;
    ntok = ntok > 16 ? 16 : ntok;
    for (int kk = 0; kk < ntok; ++kk) {
      const int t = __builtin_amdgcn_readfirstlane(tbase + kk * tstride);
      const int e0 = p.EIDX[(size_t)t * 128 + lane], e1 = p.EIDX[(size_t)t * 128 + 64 + lane];
      const float q0 = p.GATE[(size_t)t * 128 + lane], q1 = p.GATE[(size_t)t * 128 + 64 + lane];
      const int k0 = e0 >> 9, k1 = e1 >> 9;
      int base = 0, pos0 = 0, pos1 = 0;
#pragma unroll 4
      for (int r = 0; r < 32; ++r) {
        const unsigned long long m0 = __ballot(k0 == r), m1 = __ballot(k1 == r);
        const int c0 = __popcll(m0), c1 = __popcll(m1);
        const int lt0 = __builtin_amdgcn_mbcnt_hi((unsigned)(m0 >> 32), __builtin_amdgcn_mbcnt_lo((unsigned)m0, 0u));
        const int lt1 = __builtin_amdgcn_mbcnt_hi((unsigned)(m1 >> 32), __builtin_amdgcn_mbcnt_lo((unsigned)m1, 0u));
        if (k0 == r) pos0 = base + lt0;
        if (k1 == r) pos1 = base + c0 + lt1;
        base += c0 + c1;
      }
      int* SE = (int*)(SW + kk * 1024);
      float* SG = (float*)(SW + kk * 1024 + 512);
      SE[pos0] = e0; SE[pos1] = e1; SG[pos0] = q0; SG[pos1] = q1;
    }
    __builtin_amdgcn_wave_barrier();
    uint4 cb[8], nb[8];
#define PX_LOAD(DST, TAB, KK, B)                                                         \
    {                                                                                    \
      const int4 ea_ = *(const int4*)(SW + (KK) * 1024 + (B) * 32);                      \
      const int4 eb_ = *(const int4*)(SW + (KK) * 1024 + (B) * 32 + 16);                 \
      const int ei_[8] = {ea_.x, ea_.y, ea_.z, ea_.w, eb_.x, eb_.y, eb_.z, eb_.w};       \
      _Pragma("unroll") for (int k_ = 0; k_ < 8; ++k_)                                   \
        DST[k_] = *((const uint4*)((TAB) + (size_t)__builtin_amdgcn_readfirstlane(ei_[k_]) * D) + lane); \
    }
    for (int g0 = 0; g0 < ntok; g0 += UG) {
      uint4 ha[UG], hb[UG];
      float alo[UG], ahi[UG];
      int kidx[UG];
#pragma unroll
      for (int i = 0; i < UG; ++i) {
        kidx[i] = (g0 + i < ntok) ? g0 + i : ntok - 1;
        const int t = __builtin_amdgcn_readfirstlane(tbase + kidx[i] * tstride);
        ha[i] = *(const uint4*)&p.H2b[(size_t)t * D + lane * 16];
        hb[i] = *(const uint4*)&p.H2b[(size_t)t * D + lane * 16 + 8];
        alo[i] = 0.f; ahi[i] = 0.f;
      }
#define PX_UCOMP(SRC, I, B)                                                              \
      {                                                                                  \
        float pv_[8];                                                                    \
        _Pragma("unroll") for (int k = 0; k < 8; ++k) pv_[k] = dot16_fp8_bf16(SRC[k], ha[I], hb[I]); \
        const float s_ = reduce8_scatter(pv_, lane);                                     \
        if ((B) < 8) alo[I] = ((lane >> 3) == ((B) & 7)) ? s_ : alo[I]; else ahi[I] = ((lane >> 3) == ((B) & 7)) ? s_ : ahi[I]; \
      }
      PX_LOAD(cb, U8, kidx[0], 0)
      for (int b = 0; b < 16; ++b) {
#pragma unroll
        for (int i = 0; i < UG; i += 2) {
          PX_LOAD(nb, U8, kidx[i + 1], b)
          PX_UCOMP(cb, i, b)
          if (i + 2 < UG) { PX_LOAD(cb, U8, kidx[i + 2], b) } else if (b + 1 < 16) { PX_LOAD(cb, U8, kidx[0], b + 1) }
          PX_UCOMP(nb, i + 1, b)
        }
      }
#pragma unroll
      for (int i = 0; i < UG; ++i) {
        const int* SE = (const int*)(SW + kidx[i] * 1024);
        float* SG = (float*)(SW + kidx[i] * 1024 + 512);
        const int e_lo = SE[lane], e_hi = SE[64 + lane];
        const float w_lo = SG[lane] * gelu_f(alo[i] * USC[e_lo]) * VSC[e_lo], w_hi = SG[64 + lane] * gelu_f(ahi[i] * USC[e_hi]) * VSC[e_hi];
        __builtin_amdgcn_wave_barrier();
        if (g0 + i < ntok) { SG[lane] = w_lo; SG[64 + lane] = w_hi; }
        __builtin_amdgcn_wave_barrier();
      }
    }
    for (int g0 = 0; g0 < ntok; g0 += VG) {
      float f[VG][16];
      int kidx[VG];
#pragma unroll
      for (int i = 0; i < VG; ++i) {
        kidx[i] = (g0 + i < ntok) ? g0 + i : ntok - 1;
#pragma unroll
        for (int q = 0; q < 16; ++q) f[i][q] = 0.f;
      }
      uint4 vc[4], vn[4];
#define PX_LOAD4(DST, KK, B)                                                             \
      {                                                                                  \
        const int4 ea_ = *(const int4*)(SW + (KK) * 1024 + (B) * 16);                    \
        const int ei_[4] = {ea_.x, ea_.y, ea_.z, ea_.w};                                 \
        _Pragma("unroll") for (int k_ = 0; k_ < 4; ++k_)                                 \
          DST[k_] = *((const uint4*)(V8 + (size_t)__builtin_amdgcn_readfirstlane(ei_[k_]) * D) + lane); \
      }
#define PX_VCOMP4(SRC, I, B)                                                             \
      {                                                                                  \
        const float4 wa_ = *(const float4*)(SW + kidx[I] * 1024 + 512 + (B) * 16);       \
        const float ww_[4] = {wa_.x, wa_.y, wa_.z, wa_.w};                               \
        _Pragma("unroll") for (int k = 0; k < 4; ++k) {                                  \
          const float we = __int_as_float(__builtin_amdgcn_readfirstlane(__float_as_int(ww_[k]))); \
          float v[16];                                                                   \
          fp8x16_to_f32(SRC[k], v);                                                      \
          _Pragma("unroll") for (int q = 0; q < 16; ++q) f[I][q] += we * v[q];           \
        }                                                                                \
      }
      PX_LOAD4(vc, kidx[0], 0)
      for (int b = 0; b < 32; ++b) {
#pragma unroll
        for (int i = 0; i < VG; i += 2) {
          PX_LOAD4(vn, kidx[i + 1], b)
          PX_VCOMP4(vc, i, b)
          if (i + 2 < VG) { PX_LOAD4(vc, kidx[i + 2], b) } else if (b + 1 < 32) { PX_LOAD4(vc, kidx[0], b + 1) }
          PX_VCOMP4(vn, i + 1, b)
        }
      }
#pragma unroll
      for (int i = 0; i < VG; ++i) {
        if (g0 + i < ntok) {
          const int t = __builtin_amdgcn_readfirstlane(tbase + kidx[i] * tstride);
          const float* m = mod_l + (size_t)cond_of(t) * 6144;
          const float* mn = mod_n + (size_t)cond_of(t) * 6144;
          const int d0 = lane * 16;
          float v[16];
          float s = 0.f;
          {
            float mx16[16];
            ld16b(p.MIXb + (size_t)t * D + d0, mx16);
            const float mu1 = p.LN1S[2 * t], r1 = p.LN1S[2 * t + 1];
#pragma unroll
            for (int q = 0; q < 4; ++q) {
              const float4 g1 = *(const float4*)&in.ln1_g[l * D + d0 + q * 4], b1 = *(const float4*)&in.ln1_b[l * D + d0 + q * 4];
              const float4 ga = *(const float4*)&m[5120 + d0 + q * 4];
              v[q * 4 + 0] = ALPHA * ((mx16[q * 4 + 0] - mu1) * r1 * g1.x + b1.x) + ga.x * f[i][q * 4 + 0];
              v[q * 4 + 1] = ALPHA * ((mx16[q * 4 + 1] - mu1) * r1 * g1.y + b1.y) + ga.y * f[i][q * 4 + 1];
              v[q * 4 + 2] = ALPHA * ((mx16[q * 4 + 2] - mu1) * r1 * g1.z + b1.z) + ga.z * f[i][q * 4 + 2];
              v[q * 4 + 3] = ALPHA * ((mx16[q * 4 + 3] - mu1) * r1 * g1.w + b1.w) + ga.w * f[i][q * 4 + 3];
            }
          }
#pragma unroll
          for (int q = 0; q < 16; ++q) s += v[q];
          const float mu = wave_sum_u(s) * (1.f / 1024.f);
          float sq = 0.f;
#pragma unroll
          for (int q = 0; q < 16; ++q) { v[q] -= mu; sq += v[q] * v[q]; }
          const float r = rsqrtf(wave_sum_u(sq) * (1.f / 1024.f) + LN_EPS);
          float o[16];
#pragma unroll
          for (int q = 0; q < 4; ++q) {
            float4 gg = *(const float4*)&in.ln2_g[l * D + d0 + q * 4], bb = *(const float4*)&in.ln2_b[l * D + d0 + q * 4];
            o[q * 4 + 0] = v[q * 4 + 0] * r * gg.x + bb.x; o[q * 4 + 1] = v[q * 4 + 1] * r * gg.y + bb.y;
            o[q * 4 + 2] = v[q * 4 + 2] * r * gg.z + bb.z; o[q * 4 + 3] = v[q * 4 + 3] * r * gg.w + bb.w;
          }
          if (l < DEPTH - 1) {
            *(uint4*)&p.Xb[(size_t)t * D + d0] = make_uint4(pack2bf(o[0], o[1]), pack2bf(o[2], o[3]), pack2bf(o[4], o[5]), pack2bf(o[6], o[7]));
            *(uint4*)&p.Xb[(size_t)t * D + d0 + 8] = make_uint4(pack2bf(o[8], o[9]), pack2bf(o[10], o[11]), pack2bf(o[12], o[13]), pack2bf(o[14], o[15]));
          }
          if (l == DEPTH - 1) {
#pragma unroll
            for (int q = 0; q < 4; ++q) *(float4*)&p.out[(size_t)t * D + d0 + q * 4] = make_float4(o[q * 4], o[q * 4 + 1], o[q * 4 + 2], o[q * 4 + 3]);
          } else {
            unsigned hq[8];
#pragma unroll
            for (int q = 0; q < 8; ++q) {
              const int d = d0 + q * 2;
              hq[q] = pack2bf(o[q * 2] * (1.f + mn[1024 + d]) + mn[d], o[q * 2 + 1] * (1.f + mn[1024 + d + 1]) + mn[d + 1]);
            }
            *(uint4*)&p.Hb[(size_t)t * D + d0] = make_uint4(hq[0], hq[1], hq[2], hq[3]);
            *(uint4*)&p.Hb[(size_t)t * D + d0 + 8] = make_uint4(hq[4], hq[5], hq[6], hq[7]);
          }
        }
      }
    }
    __builtin_amdgcn_wave_barrier();
  }
}

__device__ void ln1_phase(const P& p, int l, char* smem, const int g_wbase) {
  const In& in = p.in;
  const int tid = otid(g_wbase), lane = tid & 63, w = tid >> 6;
  const float* mod_l = p.MOD + (size_t)l * NCOND * 6144;
  for (int t = blockIdx.x * 4 + w; t < T; t += gridDim.x * 4) {
    const float* m = mod_l + (size_t)cond_of(t) * 6144;
    const int d0 = lane * 16;
    float v[16];
    float s = 0.f;
    ld16b(p.MIXb + (size_t)t * D + d0, v);
#pragma unroll
    for (int q = 0; q < 16; ++q) s += v[q];
    const float mu = wave_sum_u(s) * (1.f / 1024.f);
    float sq = 0.f;
#pragma unroll
    for (int i = 0; i < 16; ++i) { v[i] -= mu; sq += v[i] * v[i]; }
    const float r = rsqrtf(wave_sum_u(sq) * (1.f / 1024.f) + LN_EPS);
    unsigned hq[8];
#pragma unroll
    for (int q = 0; q < 4; ++q) {
      float4 gg = *(const float4*)&in.ln1_g[l * D + d0 + q * 4], bb = *(const float4*)&in.ln1_b[l * D + d0 + q * 4];
      float4 sc = *(const float4*)&m[4096 + d0 + q * 4], sh = *(const float4*)&m[3072 + d0 + q * 4];
      float x0 = v[q * 4] * r * gg.x + bb.x, x1 = v[q * 4 + 1] * r * gg.y + bb.y, x2 = v[q * 4 + 2] * r * gg.z + bb.z, x3 = v[q * 4 + 3] * r * gg.w + bb.w;
      hq[q * 2] = pack2bf(x0 * (1.f + sc.x) + sh.x, x1 * (1.f + sc.y) + sh.y);
      hq[q * 2 + 1] = pack2bf(x2 * (1.f + sc.z) + sh.z, x3 * (1.f + sc.w) + sh.w);
    }
    *(uint4*)&p.H2b[(size_t)t * D + d0] = make_uint4(hq[0], hq[1], hq[2], hq[3]);
    *(uint4*)&p.H2b[(size_t)t * D + d0 + 8] = make_uint4(hq[4], hq[5], hq[6], hq[7]);
    if (lane == 0) { p.LN1S[2 * t] = mu; p.LN1S[2 * t + 1] = r; }
  }
}


__device__ void tabconv_share(const P& p, int l, const int g_wbase) {
  const In& in = p.in;
  const int tid = otid(g_wbase), lane = tid & 63, w = tid >> 6;
  const int nrow_blk = (32768 + (int)gridDim.x - 1) / (int)gridDim.x;
  const int r_begin = blockIdx.x * nrow_blk, r_end = min(32768, r_begin + nrow_blk);
  for (int r0 = r_begin + w * 2; r0 < r_end; r0 += 8) {
    f32x4 cv[2][4];
#pragma unroll
    for (int u = 0; u < 2; ++u) {
      const int cr = r0 + u;
      if (cr < r_end) {
        const float* s = (cr < 16384 ? in.peer_u + ((size_t)l * 16384 + cr) * D : in.peer_v + ((size_t)l * 16384 + (cr - 16384)) * D) + lane * 16;
#pragma unroll
        for (int q = 0; q < 4; ++q) cv[u][q] = __builtin_nontemporal_load((const f32x4*)s + q);
      }
    }
#pragma unroll
    for (int u = 0; u < 2; ++u) {
      const int cr = r0 + u;
      if (cr < r_end) {
        const bool isv = cr >= 16384;
        const int rr = l * 16384 + (isv ? cr - 16384 : cr);
        float mx = 0.f;
#pragma unroll
        for (int q = 0; q < 4; ++q)
#pragma unroll
          for (int i = 0; i < 4; ++i) mx = fmaxf(mx, fabsf(cv[u][q][i]));
        mx = wave_max_u(mx);
        const float sc = mx > 0.f ? 448.f / mx : 1.f;
        unsigned qq[4];
#pragma unroll
        for (int q = 0; q < 4; ++q) {
          int tt = 0;
          tt = __builtin_amdgcn_cvt_pk_fp8_f32(cv[u][q][0] * sc, cv[u][q][1] * sc, tt, false);
          tt = __builtin_amdgcn_cvt_pk_fp8_f32(cv[u][q][2] * sc, cv[u][q][3] * sc, tt, true);
          qq[q] = (unsigned)tt;
        }
        *(uint4*)((isv ? p.V8 : p.U8) + (size_t)rr * D + lane * 16) = make_uint4(qq[0], qq[1], qq[2], qq[3]);
        if (lane == 0) (isv ? p.VSC : p.USC)[rr] = mx > 0.f ? mx * (1.f / 448.f) : 1.f;
      }
    }
  }
}

#define XB_TMO      128
#define XB_XCNT(j)  (256  + 64 * (j))
#define XB_XSUB(j)  (1280 + 64 * (j))
#define XB_XGEN(j)  (2304 + 64 * (j))
#define XB_TOP      3328
#define XB_TOPGEN   3392
#define XCD_BAR_WORDS 3456
#define XB_SPIN_CAP (1u << 22)
#define LAS __attribute__((address_space(3)))
__device__ __forceinline__ unsigned xb_ld(unsigned* q)              { return __hip_atomic_load(q, __ATOMIC_RELAXED, __HIP_MEMORY_SCOPE_AGENT); }
__device__ __forceinline__ unsigned xb_add(unsigned* q, unsigned v) { return __hip_atomic_fetch_add(q, v, __ATOMIC_RELAXED, __HIP_MEMORY_SCOPE_AGENT); }
__device__ __forceinline__ unsigned xb_xcc_id() { return (unsigned)__builtin_amdgcn_s_getreg((3 << 11) | 20) & 0xFu; }
#define XB_SPIN(cond, bar) do { unsigned _sp = 0; while (cond) { __builtin_amdgcn_s_sleep(1); \
    if ((++_sp & 255u) == 0u) { if (xb_ld(&(bar)[XB_TMO])) break; if (_sp > XB_SPIN_CAP) { atomicAdd(&(bar)[XB_TMO], 1u); break; } } } } while (0)
struct XcdBarrier { unsigned* bar; unsigned x; volatile LAS unsigned* st; };
__device__ __forceinline__ XcdBarrier xcd_barrier_post(unsigned* bar, volatile LAS unsigned* st) {
  XcdBarrier b; b.bar = bar; b.x = xb_xcc_id(); b.st = st;
  if (threadIdx.x == 0) (void)xb_add(&bar[XB_XCNT(b.x)], 1u);
  return b;
}
__device__ __forceinline__ void xcd_barrier_complete(unsigned* bar, unsigned x, unsigned& nloc, unsigned& nx) {
  const unsigned G = gridDim.x * gridDim.y * gridDim.z;
  unsigned sum, cnt, mine, sp = 0u;
  for (;;) {
    sum = 0u; cnt = 0u; mine = 0u;
#pragma unroll
    for (unsigned j = 0; j < 16; ++j) { const unsigned c = xb_ld(&bar[XB_XCNT(j)]); sum += c; cnt += (c > 0u) ? 1u : 0u; mine = (j == x) ? c : mine; }
    if (sum == G) break;
    __builtin_amdgcn_s_sleep(1);
    if ((++sp & 255u) == 0u) { if (xb_ld(&bar[XB_TMO])) break; if (sp > XB_SPIN_CAP) { atomicAdd(&bar[XB_TMO], 1u); break; } }
  }
  nloc = mine > 0u ? mine : 1u; nx = cnt > 0u ? cnt : 1u;
}
__device__ __forceinline__ void xcd_barrier(const XcdBarrier& b) {
  asm volatile("s_waitcnt vmcnt(0)" ::: "memory");
  __syncthreads();
  if (threadIdx.x == 0) {
    unsigned* bar = b.bar;
    unsigned bx = b.x;
    asm volatile("" : "+v"(bx));
    __builtin_amdgcn_s_waitcnt(0);
    unsigned nloc = b.st[0], nx = b.st[1];
    if (nloc == 0u) { xcd_barrier_complete(bar, bx, nloc, nx); b.st[0] = nloc; b.st[1] = nx; }
    const unsigned old = xb_add(&bar[XB_XSUB(bx)], 1u);
    const unsigned gen = old / nloc;
    if (old + 1u == (gen + 1u) * nloc) {
      __builtin_amdgcn_fence(__ATOMIC_RELEASE, "agent");
      asm volatile("s_waitcnt vmcnt(0)" ::: "memory");
      const unsigned og = xb_add(&bar[XB_TOP], 1u);
      const unsigned tg = og / nx;
      if (og + 1u == (tg + 1u) * nx) xb_add(&bar[XB_TOPGEN], 1u);
      else XB_SPIN(xb_ld(&bar[XB_TOPGEN]) == tg, bar);
      __builtin_amdgcn_fence(__ATOMIC_ACQUIRE, "agent");
      xb_add(&bar[XB_XGEN(bx)], 1u);
      asm volatile("s_waitcnt vmcnt(0)" ::: "memory");
    } else {
      XB_SPIN(xb_ld(&bar[XB_XGEN(bx)]) == gen, bar);
      __builtin_amdgcn_fence(__ATOMIC_ACQUIRE, "agent");
      asm volatile("s_waitcnt vmcnt(0)" ::: "memory");
    }
  }
  __syncthreads();
}

constexpr int SMEM_BYTES = 65536 + 4096;
__global__ void __launch_bounds__(256, 2) fwd_megakernel(P p) {
  cg::grid_group grid = cg::this_grid();
  const int g_wbase = __builtin_amdgcn_readfirstlane((int)threadIdx.x & ~63);
  __shared__ __attribute__((aligned(16))) char smem[SMEM_BYTES];
  __shared__ uint4 xb_words;
  if (threadIdx.x == 0) xb_words = make_uint4(0u, 0u, 0u, 0u);
  __syncthreads();
  XcdBarrier xb = xcd_barrier_post(p.BAR, (volatile LAS unsigned*)&xb_words);
  mod_fast_phase(p, smem, g_wbase);
  rope_table_phase(p);
  wtrans_phase(p, smem, g_wbase);
  keysconv_phase(p);
  cacheconv_phase(p);
  if (p.use_cg_sync) grid.sync();
  xcd_barrier(xb);
  modulate_phase(p, 0);
  xcd_barrier(xb);
  for (int l = 0; l < DEPTH; ++l) {
    gemm_phase<0>(p, l, p.Hb, p.WinT + (size_t)l * INW * D, nullptr, p.Z, INW, smem, g_wbase);
    xcd_barrier(xb);
    attn_phase(p, l, smem, g_wbase);
    ret_phase(p, l, smem, g_wbase);
    gmlp_phase(p, l, smem, g_wbase);
    conv_fast_phase(p, l, smem, g_wbase);
    ret_state_phase(p, l, smem, g_wbase);
    xcd_barrier(xb);
    gemm_phase<1>(p, l, p.MIXCATb, p.WoutT + (size_t)l * D * D, nullptr, nullptr, D, smem, g_wbase);
    xcd_barrier(xb);
    ln1_phase(p, l, smem, g_wbase);
    xcd_barrier(xb);
    const bool conv_first = (blockIdx.x * 2 >= gridDim.x);
    if (conv_first) tabconv_share(p, l, g_wbase);
    gemm_phase<2>(p, l, p.H2b, p.WqT + (size_t)l * D * D, nullptr, p.Qb, D, smem, g_wbase);
    if (!conv_first) tabconv_share(p, l, g_wbase);
    xcd_barrier(xb);
    peerx_phase<8, 4>(p, l, smem, g_wbase);
    xcd_barrier(xb);
  }
}

extern "C" void kernel_launch(void* const* d_in, const int* in_sizes, int n_in, void* d_out, int out_size,
                              void* d_ws, size_t ws_size, hipStream_t stream) {
  static int grid_blocks = 0;
  if (!grid_blocks) {
    int dev = 0, cus = 0, per_cu = 0;
    (void)hipGetDevice(&dev);
    (void)hipDeviceGetAttribute(&cus, hipDeviceAttributeMultiprocessorCount, dev);
    (void)hipOccupancyMaxActiveBlocksPerMultiprocessor(&per_cu, fwd_megakernel, 256, 0);
    if (per_cu > 2) per_cu = 2;
    if (per_cu < 1) per_cu = 1;
    grid_blocks = cus * per_cu;
  }
  P p{};
  const float** ip = (const float**)&p.in;
  for (int i = 0; i < 30; ++i) ip[i] = (const float*)d_in[i];
  p.out = (float*)d_out;
  float* ws = (float*)d_ws;
  size_t off = 0;
  auto take = [&](size_t n) { float* q = ws + off; off += (n + 63) & ~(size_t)63; return q; };
  p.BAR = (unsigned*)take(XCD_BAR_WORDS);
  (void)hipMemsetAsync(p.BAR, 0, XCD_BAR_WORDS * sizeof(unsigned), stream);
  p.MOD = take((size_t)DEPTH * NCOND * 6144);
  p.ROPE = (float2*)take(1024);
  p.X = take((size_t)T * D);
  p.Hb = (bf16_t*)take((size_t)T * D / 2);
  p.Z = (bf16_t*)take((size_t)T * INW / 2);
  p.MIXCATb = (bf16_t*)take((size_t)T * D / 2);
  p.H2b = (bf16_t*)take((size_t)T * D / 2);
  p.WinT = (bf16_t*)take((size_t)DEPTH * INW * D / 2);
  p.WoutT = (bf16_t*)take((size_t)DEPTH * D * D / 2);
  p.WqT = (bf16_t*)take((size_t)DEPTH * D * D / 2);
  p.U8 = (unsigned char*)take((size_t)DEPTH * 16384 * D / 4);
  p.V8 = (unsigned char*)take((size_t)DEPTH * 16384 * D / 4);
  p.USC = take((size_t)DEPTH * 16384);
  p.VSC = take((size_t)DEPTH * 16384);
  p.Qb = (bf16_t*)take((size_t)T * D / 2);
  p.KEYSb = (bf16_t*)take((size_t)DEPTH * 2 * 128 * 64 / 2);
  p.CKb = (bf16_t*)take((size_t)8 * DEPTH * 512 * 256 / 2);
  p.CVb = (bf16_t*)take((size_t)8 * DEPTH * 512 * 256 / 2);
  p.MIX = take((size_t)T * D);
  p.X1 = take((size_t)T * D);
  p.LN1S = take((size_t)T * 2);
  p.MIXb = (bf16_t*)take((size_t)T * D / 2);
  p.Xb = (bf16_t*)take((size_t)T * D / 2);
  p.EIDX = (int*)take((size_t)T * 128);
  p.GATE = take((size_t)T * 128);
  void* args[] = {&p};
  hipError_t e = hipLaunchCooperativeKernel((void*)fwd_megakernel, dim3(grid_blocks), dim3(256), args, 0, stream);
  if (e != hipSuccess) fprintf(stderr, "cooperative launch failed: %s (grid %d)\n", hipGetErrorString(e), grid_blocks);
}
```

```cpp
#include <hip/hip_runtime.h>
#include <hip/hip_cooperative_groups.h>
#include <stdint.h>
#include <cstdio>
namespace cg = cooperative_groups;

constexpr int D = 1024;
constexpr int T = 16384;
constexpr int TCTX = 8192;
constexpr int INW = 2816;
constexpr int DEPTH = 4;
constexpr int NCOND = 9;
constexpr float LN_EPS = 1e-5f;
constexpr float ALPHA = 1.681792830507429f;

constexpr int C_QA = 0, C_KA = 256, C_VA = 512, C_UB = 768, C_VB = 1024, C_QC = 1280, C_KC = 1536,
              C_VC = 1792, C_GC = 2048, C_AD = 2304, C_BD = 2560;

constexpr size_t O_YP = 0, O_YS = 8388608, O_NK = 16777216, O_NV = 25165824, O_NS = 33554432;

struct In {
  const float *x_prompt, *x_sample, *cache_k, *cache_v, *state_ret, *c, *c_ctx, *w_mod, *b_mod, *w_in,
      *diff_lambda, *diff_subln_g, *gmlp_ln_g, *gmlp_ln_b, *gmlp_ws, *gmlp_bs, *ret_decay, *conv_w, *conv_b,
      *conv_ln_g, *conv_ln_b, *w_out, *ln1_g, *ln1_b, *ln2_g, *ln2_b, *peer_wq, *peer_keys, *peer_u, *peer_v;
};

__device__ __forceinline__ float sigmoid_f(float x) { return __builtin_amdgcn_rcpf(1.f + __builtin_amdgcn_exp2f(-1.4426950408889634f * x)); }
__device__ __forceinline__ float silu_f(float x) { return x * sigmoid_f(x); }
__device__ __forceinline__ float gelu_f(float x) {
  float u = 0.7978845608028654f * (x + 0.044715f * x * x * x);
  return x * sigmoid_f(2.f * u);
}
__device__ __forceinline__ int cond_of(int t) { return t < TCTX ? 0 : 1 + ((t - TCTX) >> 10); }
__device__ __forceinline__ float lam_init(int l) { return 0.8f - 0.6f * expf(-0.3f * (float)l); }

__device__ __forceinline__ int olane_() { int l_; asm volatile("v_mbcnt_lo_u32_b32 %0, -1, 0\n\tv_mbcnt_hi_u32_b32 %0, -1, %0" : "=v"(l_)); return l_; }
__device__ __forceinline__ float shx(float v, int off) { return __int_as_float(__builtin_amdgcn_ds_bpermute((olane_() ^ off) << 2, __float_as_int(v))); }
__device__ __forceinline__ int shx(int v, int off) { return __builtin_amdgcn_ds_bpermute((olane_() ^ off) << 2, v); }
__device__ __forceinline__ float wave_sum(float v) {
#pragma unroll
  for (int o = 32; o > 0; o >>= 1) v += shx(v, o);
  return v;
}
__device__ __forceinline__ float block_sum256(float v, float* red) {
  v = wave_sum(v);
  __syncthreads();
  if ((threadIdx.x & 63) == 0) red[threadIdx.x >> 6] = v;
  __syncthreads();
  return red[0] + red[1] + red[2] + red[3];
}

typedef unsigned short bf16_t;
using bf16x8 = __attribute__((ext_vector_type(8))) short;
using f32x4 = __attribute__((ext_vector_type(4))) float;
typedef __bf16 hwbf2_t __attribute__((ext_vector_type(2)));
typedef float hwf2_t __attribute__((ext_vector_type(2)));
__device__ __forceinline__ unsigned pack2bf(float a, float b) {
  hwf2_t v = {a, b};
  return __builtin_bit_cast(unsigned, __builtin_convertvector(v, hwbf2_t));
}
__device__ __forceinline__ bf16_t f2bf(float f) { return (bf16_t)(pack2bf(f, 0.f) & 0xffffu); }
__device__ __forceinline__ float bf2f(bf16_t h) { return __uint_as_float(((unsigned)h) << 16); }
__device__ __forceinline__ void ld16(const float* s, float* v) {
  float4 a = *(const float4*)s, b = *(const float4*)(s + 4), c = *(const float4*)(s + 8), d = *(const float4*)(s + 12);
  v[0] = a.x; v[1] = a.y; v[2] = a.z; v[3] = a.w; v[4] = b.x; v[5] = b.y; v[6] = b.z; v[7] = b.w;
  v[8] = c.x; v[9] = c.y; v[10] = c.z; v[11] = c.w; v[12] = d.x; v[13] = d.y; v[14] = d.z; v[15] = d.w;
}
__device__ __forceinline__ void ld8(const float* s, float* v) {
  float4 a = *(const float4*)s, b = *(const float4*)(s + 4);
  v[0] = a.x; v[1] = a.y; v[2] = a.z; v[3] = a.w; v[4] = b.x; v[5] = b.y; v[6] = b.z; v[7] = b.w;
}
__device__ __forceinline__ void ld8b(const bf16_t* s, float* v) {
  uint4 q = *(const uint4*)s;
  v[0] = __uint_as_float(q.x << 16); v[1] = __uint_as_float(q.x & 0xffff0000u); v[2] = __uint_as_float(q.y << 16); v[3] = __uint_as_float(q.y & 0xffff0000u);
  v[4] = __uint_as_float(q.z << 16); v[5] = __uint_as_float(q.z & 0xffff0000u); v[6] = __uint_as_float(q.w << 16); v[7] = __uint_as_float(q.w & 0xffff0000u);
}
__device__ __forceinline__ void ld16b(const bf16_t* s, float* v) { ld8b(s, v); ld8b(s + 8, v + 8); }
__device__ __forceinline__ int ksw(int row, int chunk) { return row * 128 + ((chunk ^ ((row >> 1) & 7)) << 4); }
__device__ __forceinline__ int otid(int wbase) {
  int t;
  asm volatile("v_mbcnt_lo_u32_b32 %0, -1, 0\n\tv_mbcnt_hi_u32_b32 %0, -1, %0" : "=v"(t));
  t += wbase;
  asm volatile("" : "+v"(t));
  return t;
}

struct P {
  In in;
  float* out;
  float *MOD, *X, *MIX, *X1, *GATE, *LN1S;
  bf16_t* Z;
  bf16_t *Hb, *MIXCATb, *H2b, *WinT, *WoutT, *WqT, *Qb, *KEYSb, *CKb, *CVb, *MIXb, *Xb;
  unsigned char *U8, *V8;
  float *USC, *VSC;
  float2* ROPE;
  int* EIDX;
  unsigned* BAR;
  int use_cg_sync;
  int pad_;
};

#define FOR_VB(G) for (int vb = blockIdx.x; vb < (G); vb += gridDim.x)


__device__ void rope_table_phase(const P& p) {
  FOR_VB(2) {
    int idx = vb * 256 + threadIdx.x;
    int pos = idx >> 3, i = idx & 7;
    float inv = powf(10000.f, -(float)i / 8.f);
    float angf = (float)pos * inv;
    double x = (double)angf;
    double kq = rint(x * 0.6366197723675814);
    double r = x - kq * 1.5707963267948966;
    double r2 = r * r;
    double s = r * (1.0 + r2 * (-1.0 / 6 + r2 * (1.0 / 120 + r2 * (-1.0 / 5040 + r2 * (1.0 / 362880 + r2 * (-1.0 / 39916800 + r2 * (1.0 / 6227020800.0)))))));
    double c = 1.0 + r2 * (-0.5 + r2 * (1.0 / 24 + r2 * (-1.0 / 720 + r2 * (1.0 / 40320 + r2 * (-1.0 / 3628800 + r2 * (1.0 / 479001600.0 + r2 * (-1.0 / 87178291200.0)))))));
    int q = ((int)kq) & 3;
    double cs, sn;
    if (q == 0) { cs = c; sn = s; }
    else if (q == 1) { cs = -s; sn = c; }
    else if (q == 2) { cs = -c; sn = -s; }
    else { cs = s; sn = -c; }
    p.ROPE[idx] = make_float2((float)cs, (float)sn);
  }
}

__device__ void copy_x_phase(const P& p) {
  for (size_t i = (size_t)blockIdx.x * 256 + threadIdx.x; i < (size_t)T * D / 4; i += (size_t)gridDim.x * 256) {
    size_t e = i * 4;
    float4 v = e < (size_t)TCTX * D ? *(const float4*)&p.in.x_prompt[e] : *(const float4*)&p.in.x_sample[e - (size_t)TCTX * D];
    *(float4*)&p.X[e] = v;
  }
}

__device__ void modulate_phase(const P& p, int l) {
  const float* mod_l = p.MOD + (size_t)l * NCOND * 6144;
  for (size_t i8 = (size_t)blockIdx.x * 256 + threadIdx.x; i8 < (size_t)T * D / 8; i8 += (size_t)gridDim.x * 256) {
    const size_t idx = i8 * 8;
    const int t = (int)(idx >> 10), d = (int)(idx & 1023);
    const float* m = mod_l + (size_t)cond_of(t) * 6144;
    const float* xs = idx < (size_t)TCTX * D ? p.in.x_prompt + idx : p.in.x_sample + (idx - (size_t)TCTX * D);
    const float4 xa = *(const float4*)xs, xb = *(const float4*)(xs + 4);
    const float4 sa = *(const float4*)(m + 1024 + d), sb = *(const float4*)(m + 1024 + d + 4);
    const float4 ha = *(const float4*)(m + d), hb = *(const float4*)(m + d + 4);
    *(uint4*)&p.Hb[idx] = make_uint4(pack2bf(xa.x * (1.f + sa.x) + ha.x, xa.y * (1.f + sa.y) + ha.y), pack2bf(xa.z * (1.f + sa.z) + ha.z, xa.w * (1.f + sa.w) + ha.w),
                                     pack2bf(xb.x * (1.f + sb.x) + hb.x, xb.y * (1.f + sb.y) + hb.y), pack2bf(xb.z * (1.f + sb.z) + hb.z, xb.w * (1.f + sb.w) + hb.w));
  }
}


template <int CTRL, int ROWMASK>
__device__ __forceinline__ float dpp_add(float v) {
  int t = __builtin_amdgcn_update_dpp(0, __float_as_int(v), CTRL, ROWMASK, 0xf, false);
  return v + __int_as_float(t);
}
__device__ __forceinline__ float wave_sum_u(float v) {
  v = dpp_add<0xB1, 0xf>(v);
  v = dpp_add<0x4E, 0xf>(v);
  v = dpp_add<0x141, 0xf>(v);
  v = dpp_add<0x140, 0xf>(v);
  v = dpp_add<0x142, 0xa>(v);
  v = dpp_add<0x143, 0xc>(v);
  return __int_as_float(__builtin_amdgcn_readlane(__float_as_int(v), 63));
}
typedef __attribute__((ext_vector_type(2))) __bf16 bf2_t;
__device__ __forceinline__ float dot2bf(unsigned a, unsigned b, float acc) {
  return __builtin_amdgcn_fdot2_f32_bf16(__builtin_bit_cast(bf2_t, a), __builtin_bit_cast(bf2_t, b), acc, false);
}
__device__ __forceinline__ float dot8bf(uint4 a, uint4 b, float acc) {
  acc = dot2bf(a.x, b.x, acc); acc = dot2bf(a.y, b.y, acc); acc = dot2bf(a.z, b.z, acc); acc = dot2bf(a.w, b.w, acc);
  return acc;
}
__device__ __forceinline__ float bflo(unsigned x) { return __uint_as_float(x << 16); }
__device__ __forceinline__ float bfhi(unsigned x) { return __uint_as_float(x & 0xffff0000u); }

#define INS16(V, I, xv, xi)                                         \
  {                                                                 \
    float _x = (xv); int _xi = (xi);                                \
    _Pragma("unroll") for (int _i = 0; _i < 16; ++_i) {             \
      bool _gt = _x > V[_i];                                        \
      float _tv = _gt ? V[_i] : _x; int _ti = _gt ? I[_i] : _xi;    \
      V[_i] = _gt ? _x : V[_i]; I[_i] = _gt ? _xi : I[_i];          \
      _x = _tv; _xi = _ti;                                          \
    }                                                               \
  }


__device__ void wtrans_phase(const P& p, char* smem, const int g_wbase) {
  float(*tile)[65] = (float(*)[65])smem;
  const int tid = otid(g_wbase);
  FOR_VB(DEPTH * 1216) {
    int l = vb / 1216, r = vb % 1216;
    const float* W; bf16_t* Wt; int N, it;
    if (r < 704) { W = p.in.w_in + (size_t)l * D * INW; Wt = p.WinT + (size_t)l * INW * D; N = INW; it = r; }
    else if (r < 960) { W = p.in.w_out + (size_t)l * D * D; Wt = p.WoutT + (size_t)l * D * D; N = D; it = r - 704; }
    else { W = p.in.peer_wq + (size_t)l * D * D; Wt = p.WqT + (size_t)l * D * D; N = D; it = r - 960; }
    int ntn = N / 64;
    int k0 = (it / ntn) * 64, n0 = (it % ntn) * 64;
    __syncthreads();
#pragma unroll
    for (int i = 0; i < 4; ++i) {
      int e = i * 256 + tid;
      int kr = e >> 4, c4 = e & 15;
      float4 v = *(const float4*)&W[(size_t)(k0 + kr) * N + n0 + c4 * 4];
      tile[kr][c4 * 4 + 0] = v.x; tile[kr][c4 * 4 + 1] = v.y; tile[kr][c4 * 4 + 2] = v.z; tile[kr][c4 * 4 + 3] = v.w;
    }
    __syncthreads();
#pragma unroll
    for (int i = 0; i < 2; ++i) {
      int e = i * 256 + tid;
      int nr = e >> 3, kc = e & 7;
      bf16x8 o;
#pragma unroll
      for (int j = 0; j < 8; ++j) o[j] = (short)f2bf(tile[kc * 8 + j][nr]);
      const int n_ = n0 + nr, k_ = k0 + kc * 8;
      *(bf16x8*)&Wt[((size_t)((n_ >> 4) * 32 + (k_ >> 5)) * 512) + ((((k_ >> 3) & 3) * 16 + (n_ & 15)) * 8)] = o;
    }
  }
}

using f32x16 = __attribute__((ext_vector_type(16))) float;
__device__ __forceinline__ int sortable_i(float f) { int u = __float_as_int(f); return u ^ ((u >> 31) & 0x7fffffff); }
__device__ __forceinline__ float unsortable_f(int s) { return __int_as_float(s ^ ((s >> 31) & 0x7fffffff)); }
__device__ __forceinline__ void ce_desc(int& a, int& b) { int hi = max(a, b), lo = min(a, b); a = hi; b = lo; }
__device__ __forceinline__ void sort16_desc(int (&a)[16]) {
#pragma unroll
  for (int k = 2; k <= 16; k <<= 1)
#pragma unroll
    for (int j = k >> 1; j > 0; j >>= 1)
#pragma unroll
      for (int i = 0; i < 16; ++i) {
        const int q = i ^ j;
        if (q > i) { if ((i & k) == 0) ce_desc(a[i], a[q]); else ce_desc(a[q], a[i]); }
      }
}
__device__ __forceinline__ void bmerge16_desc(int (&a)[16]) {
#pragma unroll
  for (int j = 8; j > 0; j >>= 1)
#pragma unroll
    for (int i = 0; i < 16; ++i) { const int q = i ^ j; if (q > i) ce_desc(a[i], a[q]); }
}
__device__ __forceinline__ void top16_merge(int (&a)[16], const int (&b)[16]) {
#pragma unroll
  for (int i = 0; i < 16; ++i) a[i] = max(a[i], b[15 - i]);
  bmerge16_desc(a);
}
__device__ __forceinline__ void acc_keys(const f32x16& acc, int kb, int hh4, int (&a)[16]) {
#pragma unroll
  for (int i = 0; i < 16; ++i) a[i] = (sortable_i(acc[i]) & ~127) | (32 * kb + (i & 3) + 8 * (i >> 2)) | hh4;
}

constexpr int candI(int s) {
  int c = 0;
  for (int i = 0; i < 16; ++i) for (int j = 0; j < 16; ++j) if ((i + 1) * (j + 1) <= 16) { if (c == s) return i * 16 + j; ++c; }
  return -1;
}
template <int G>
__device__ __forceinline__ void cand_group(const float (&va)[16], const float (&vb)[16], int (&c)[16]) {
#pragma unroll
  for (int s = 0; s < 16; ++s) {
    constexpr int dummy = 0; (void)dummy;
    const int ij = candI(G * 16 + s);
    if (ij < 0) c[s] = (int)0x80000000;
    else c[s] = (sortable_i(va[ij >> 4] + vb[ij & 15]) & ~255) | ij;
  }
}

__device__ void topk_fast_phase(const P& p, int l, char* smem, const int g_wbase) {
  const int tid = otid(g_wbase), lane = tid & 63, w = tid >> 6, hh = lane >> 5, tk = lane & 31;
  __syncthreads();
  {
    const bf16_t* kb = p.KEYSb + (size_t)l * 2 * 128 * 64;
    for (int i = tid; i < 2048; i += 256) {
      int half = i >> 10, r = (i >> 3) & 127, c = i & 7;
      *(bf16x8*)(smem + half * 16384 + ksw(r, c)) = *(const bf16x8*)(kb + (size_t)(half * 128 + r) * 64 + c * 8);
    }
  }
  __syncthreads();
  unsigned char* IDX = (unsigned char*)(smem + 32768) + w * 1024;
  for (int item = blockIdx.x * 4 + w; item < 512 * 8; item += gridDim.x * 4) {
    const int tile = item >> 3, h = item & 7;
    const int t = tile * 32 + tk;
    int tk0[16], tk1[16];
#pragma unroll
    for (int pp = 0; pp < 2; ++pp) {
      f32x16 acc[4];
#pragma unroll
      for (int kb = 0; kb < 4; ++kb)
#pragma unroll
        for (int i = 0; i < 16; ++i) acc[kb][i] = 0.f;
#pragma unroll
      for (int ks = 0; ks < 4; ++ks) {
        bf16x8 bq = *(const bf16x8*)&p.Qb[(size_t)t * D + h * 128 + pp * 64 + ks * 16 + hh * 8];
#pragma unroll
        for (int kb = 0; kb < 4; ++kb) {
          bf16x8 ak = *(const bf16x8*)(smem + pp * 16384 + ksw(32 * kb + tk, 2 * ks + hh));
          acc[kb] = __builtin_amdgcn_mfma_f32_32x32x16_bf16(ak, bq, acc[kb], 0, 0, 0);
        }
      }
      int a[16], b[16];
      acc_keys(acc[0], 0, hh * 4, a); sort16_desc(a);
      acc_keys(acc[1], 1, hh * 4, b); sort16_desc(b); top16_merge(a, b);
      acc_keys(acc[2], 2, hh * 4, b); sort16_desc(b); top16_merge(a, b);
      acc_keys(acc[3], 3, hh * 4, b); sort16_desc(b); top16_merge(a, b);
      const int pa32_ = (olane_() ^ 32) << 2;
#pragma unroll
      for (int i = 0; i < 16; ++i) b[i] = __builtin_amdgcn_ds_bpermute(pa32_, a[i]);
      top16_merge(a, b);
#pragma unroll
      for (int i = 0; i < 16; ++i) { if (pp == 0) tk0[i] = a[i]; else tk1[i] = a[i]; }
    }
    {
      unsigned pk[4];
#pragma unroll
      for (int q4 = 0; q4 < 4; ++q4) {
        unsigned x = 0;
#pragma unroll
        for (int b4 = 0; b4 < 4; ++b4) {
          int i = q4 * 4 + b4;
          unsigned v = (unsigned)((hh ? tk1[i] : tk0[i]) & 127);
          x |= v << (8 * b4);
        }
        pk[q4] = x;
      }
      *(uint4*)(IDX + tk * 32 + hh * 16) = make_uint4(pk[0], pk[1], pk[2], pk[3]);
    }
    float va[16], vb[16];
#pragma unroll
    for (int i = 0; i < 16; ++i) { va[i] = unsortable_f(tk0[i] & ~127); vb[i] = unsortable_f(tk1[i] & ~127); }
    int c[16], d[16];
    cand_group<0>(va, vb, c); sort16_desc(c);
    cand_group<1>(va, vb, d); sort16_desc(d); top16_merge(c, d);
    cand_group<2>(va, vb, d); sort16_desc(d); top16_merge(c, d);
    cand_group<3>(va, vb, d); sort16_desc(d); top16_merge(c, d);
    __builtin_amdgcn_wave_barrier();
    float e[16], sum = 0.f;
    const float m0 = unsortable_f(c[0] & ~255);
#pragma unroll
    for (int i = 0; i < 16; ++i) { e[i] = __builtin_amdgcn_exp2f(1.4426950408889634f * (unsortable_f(c[i] & ~255) - m0)); sum += e[i]; }
    const float inv = __builtin_amdgcn_rcpf(sum);
    if (hh == 0) {
      int ex[16];
#pragma unroll
      for (int i = 0; i < 16; ++i) {
        const int ci = c[i] & 255;
        ex[i] = (int)IDX[tk * 32 + (ci >> 4)] * 128 + (int)IDX[tk * 32 + 16 + (ci & 15)];
      }
      int4* dst = (int4*)&p.EIDX[(size_t)t * 128 + h * 16];
      dst[0] = make_int4(ex[0], ex[1], ex[2], ex[3]); dst[1] = make_int4(ex[4], ex[5], ex[6], ex[7]);
      dst[2] = make_int4(ex[8], ex[9], ex[10], ex[11]); dst[3] = make_int4(ex[12], ex[13], ex[14], ex[15]);
    } else {
      float4* dst = (float4*)&p.GATE[(size_t)t * 128 + h * 16];
      dst[0] = make_float4(e[0] * inv, e[1] * inv, e[2] * inv, e[3] * inv);
      dst[1] = make_float4(e[4] * inv, e[5] * inv, e[6] * inv, e[7] * inv);
      dst[2] = make_float4(e[8] * inv, e[9] * inv, e[10] * inv, e[11] * inv);
      dst[3] = make_float4(e[12] * inv, e[13] * inv, e[14] * inv, e[15] * inv);
    }
    __builtin_amdgcn_wave_barrier();
  }
}

__device__ __forceinline__ void topk_tile(const P& p, const char* QL, const char* KL, unsigned char* IDX, int t0, int h, int lane, int w) {
  asm volatile("" : "+v"(lane));
  const int hh = lane >> 5, tk = lane & 31;
  const int qrow = 32 * w + tk;
  const int t = t0 + qrow;
  {
    int tk0[16], tk1[16];
#pragma unroll
    for (int pp = 0; pp < 2; ++pp) {
      bf16x8 bq[4];
#pragma unroll
      for (int ks = 0; ks < 4; ++ks) bq[ks] = *(const bf16x8*)(QL + qrow * 256 + (((pp * 8 + ks * 2 + hh) ^ (qrow & 15)) << 4));
      int a[16], b[16];
#pragma unroll
      for (int kb = 0; kb < 4; ++kb) {
        f32x16 acc;
#pragma unroll
        for (int i = 0; i < 16; ++i) acc[i] = 0.f;
#pragma unroll
        for (int ks = 0; ks < 4; ++ks) {
          bf16x8 ak = *(const bf16x8*)(KL + pp * 16384 + ksw(32 * kb + tk, 2 * ks + hh));
          acc = __builtin_amdgcn_mfma_f32_32x32x16_bf16(ak, bq[ks], acc, 0, 0, 0);
        }
        if (kb == 0) { acc_keys(acc, 0, hh * 4, a); sort16_desc(a); }
        else { acc_keys(acc, kb, hh * 4, b); sort16_desc(b); top16_merge(a, b); }
      }
      const int pa32_ = (olane_() ^ 32) << 2;
#pragma unroll
      for (int i = 0; i < 16; ++i) b[i] = __builtin_amdgcn_ds_bpermute(pa32_, a[i]);
      top16_merge(a, b);
#pragma unroll
      for (int i = 0; i < 16; ++i) { if (pp == 0) tk0[i] = a[i]; else tk1[i] = a[i]; }
    }
    {
      unsigned pk[4];
#pragma unroll
      for (int q4 = 0; q4 < 4; ++q4) {
        unsigned x = 0;
#pragma unroll
        for (int b4 = 0; b4 < 4; ++b4) {
          int i = q4 * 4 + b4;
          unsigned v = (unsigned)((hh ? tk1[i] : tk0[i]) & 127);
          x |= v << (8 * b4);
        }
        pk[q4] = x;
      }
      *(uint4*)(IDX + tk * 32 + hh * 16) = make_uint4(pk[0], pk[1], pk[2], pk[3]);
    }
    float va[16], vb[16];
#pragma unroll
    for (int i = 0; i < 16; ++i) { va[i] = unsortable_f(tk0[i] & ~127); vb[i] = unsortable_f(tk1[i] & ~127); }
    int c[16], d[16];
    cand_group<0>(va, vb, c); sort16_desc(c);
    cand_group<1>(va, vb, d); sort16_desc(d); top16_merge(c, d);
    cand_group<2>(va, vb, d); sort16_desc(d); top16_merge(c, d);
    cand_group<3>(va, vb, d); sort16_desc(d); top16_merge(c, d);
    __builtin_amdgcn_wave_barrier();
    float e[16], sum = 0.f;
    const float m0 = unsortable_f(c[0] & ~255);
#pragma unroll
    for (int i = 0; i < 16; ++i) { e[i] = __builtin_amdgcn_exp2f(1.4426950408889634f * (unsortable_f(c[i] & ~255) - m0)); sum += e[i]; }
    const float inv = __builtin_amdgcn_rcpf(sum);
    if (hh == 0) {
      int ex[16];
#pragma unroll
      for (int i = 0; i < 16; ++i) {
        const int ci = c[i] & 255;
        ex[i] = (int)IDX[tk * 32 + (ci >> 4)] * 128 + (int)IDX[tk * 32 + 16 + (ci & 15)];
      }
      int4* dst = (int4*)&p.EIDX[(size_t)t * 128 + h * 16];
      dst[0] = make_int4(ex[0], ex[1], ex[2], ex[3]); dst[1] = make_int4(ex[4], ex[5], ex[6], ex[7]);
      dst[2] = make_int4(ex[8], ex[9], ex[10], ex[11]); dst[3] = make_int4(ex[12], ex[13], ex[14], ex[15]);
    } else {
      float4* dst = (float4*)&p.GATE[(size_t)t * 128 + h * 16];
      dst[0] = make_float4(e[0] * inv, e[1] * inv, e[2] * inv, e[3] * inv);
      dst[1] = make_float4(e[4] * inv, e[5] * inv, e[6] * inv, e[7] * inv);
      dst[2] = make_float4(e[8] * inv, e[9] * inv, e[10] * inv, e[11] * inv);
      dst[3] = make_float4(e[12] * inv, e[13] * inv, e[14] * inv, e[15] * inv);
    }
    __builtin_amdgcn_wave_barrier();
  }
}

__device__ __forceinline__ void glds16(const void* g, void* lds) {
  __builtin_amdgcn_global_load_lds((const unsigned*)g, (unsigned*)lds, 16, 0, 0);
}
template <int EPI>
__device__ void gemm_phase(const P& p, int l, const bf16_t* __restrict__ A, const bf16_t* __restrict__ Bt, float* __restrict__ C, bf16_t* __restrict__ Cb, int N, char* smem, const int g_wbase) {
  const int tid = otid(g_wbase), lane = tid & 63, w = tid >> 6, wr = w >> 1, wc = w & 1;
  constexpr int K = 1024;
  const int ntn = N / 128;
  const int xq = blockIdx.x & 7, rk = blockIdx.x >> 3, bpx = gridDim.x >> 3;
  const int ncg = (ntn + 7) >> 3;
  for (int lt = rk; lt < ncg * 64; lt += bpx) {
    const int g64 = lt >> 6, wi = lt & 63;
    const int tm = 8 * xq + (wi & 7), tn = 8 * g64 + (wi >> 3);
    if (tn >= ntn) continue;
    const int bm = tm * 256, bn = tn * 128;
    f32x4 acc[4][8];
#pragma unroll
    for (int i = 0; i < 4; ++i)
#pragma unroll
      for (int j = 0; j < 8; ++j) acc[i][j] = f32x4{0.f, 0.f, 0.f, 0.f};
    uint4 ra0, ra1, ra2, ra3;
    bf16x8 bf0[4], bf1[4];
    const unsigned offA = (unsigned)(((bm + (tid >> 3)) * K + (((tid & 7) ^ ((tid >> 4) & 7)) << 3)) * 2);
    const unsigned offB = (unsigned)((((bn + wc * 64) >> 4) * 32) * 1024 + lane * 16);
    const int arow = wr * 128 + (lane & 15);
    const int aoffh0 = arow * 128 + ((((lane >> 4)) ^ (((lane & 15) >> 1) & 7)) << 4);
    const int aoffh1 = arow * 128 + (((4 + (lane >> 4)) ^ (((lane & 15) >> 1) & 7)) << 4);
#define GEMM_GL1(J, RA, kt, H) { RA = *(const uint4*)((const char*)A + (offA + (unsigned)(((H) * 128 + (J) * 32) * K * 2 + (kt) * 128))); }
#define GEMM_GLOAD(kt, H) { GEMM_GL1(0, ra0, kt, H) GEMM_GL1(1, ra1, kt, H) GEMM_GL1(2, ra2, kt, H) GEMM_GL1(3, ra3, kt, H) }
#define GEMM_LS1(J, RA, buf, H) { *(uint4*)(smem + (buf) * 32768 + (((H) * 4 + (J)) * 256 + tid) * 16) = RA; }
#define GEMM_LSTORE(buf, H) { GEMM_LS1(0, ra0, buf, H) GEMM_LS1(1, ra1, buf, H) GEMM_LS1(2, ra2, buf, H) GEMM_LS1(3, ra3, buf, H) }
#define GEMM_BLOAD(BF, ks) { _Pragma("unroll") for (int i_ = 0; i_ < 4; ++i_) BF[i_] = *(const bf16x8*)((const char*)Bt + (offB + (unsigned)((i_ * 32 + (ks)) * 1024))); }
#define GEMM_HALF(BC, AOFF, buf)                                                                                             \
    {                                                                                                                        \
      const char* sa_ = smem + (buf) * 32768;                                                                                \
      _Pragma("unroll") for (int q_ = 0; q_ < 2; ++q_) {                                                                     \
        bf16x8 af[4];                                                                                                        \
        _Pragma("unroll") for (int i_ = 0; i_ < 4; ++i_) af[i_] = *(const bf16x8*)(sa_ + AOFF + (q_ * 4 + i_) * 2048);       \
        __builtin_amdgcn_sched_barrier(0);                                                                                   \
        _Pragma("unroll") for (int nt = 0; nt < 4; ++nt) {                                                                   \
          _Pragma("unroll") for (int mt = 0; mt < 4; ++mt)                                                                   \
            acc[nt][q_ * 4 + mt] = __builtin_amdgcn_mfma_f32_16x16x32_bf16(BC[nt], af[mt], acc[nt][q_ * 4 + mt], 0, 0, 0);   \
        }                                                                                                                    \
        __builtin_amdgcn_sched_barrier(0);                                                                                   \
      }                                                                                                                      \
    }
    GEMM_BLOAD(bf0, 0)
    GEMM_GLOAD(0, 0)
    __syncthreads();
    GEMM_LSTORE(0, 0)
    GEMM_GLOAD(0, 1)
    GEMM_LSTORE(0, 1)
    __syncthreads();
    for (int kt = 0; kt < 16; ++kt) {
      const int cur = kt & 1, nxt = cur ^ 1;
      const bool more = kt + 1 < 16;
      GEMM_BLOAD(bf1, 2 * kt + 1)
      if (more) GEMM_GLOAD(kt + 1, 0)
      __builtin_amdgcn_sched_barrier(0);
      GEMM_HALF(bf0, aoffh0, cur)
      if (more) GEMM_LSTORE(nxt, 0)
      if (more) { GEMM_BLOAD(bf0, 2 * kt + 2) GEMM_GLOAD(kt + 1, 1) }
      __builtin_amdgcn_sched_barrier(0);
      GEMM_HALF(bf1, aoffh1, cur)
      if (more) GEMM_LSTORE(nxt, 1)
      __syncthreads();
    }
    if (EPI == 2) {
      char* QL = smem;
      char* KL = smem + 32768;
      {
        const bf16_t* kb = p.KEYSb + (size_t)l * 2 * 128 * 64;
        int t2 = tid;
        asm volatile("" : "+v"(t2));
#pragma unroll
        for (int i = 0; i < 8; ++i) {
          const int e = i * 256 + t2;
          const int half = e >> 10, r = (e >> 3) & 127, c = e & 7;
          *(bf16x8*)(KL + half * 16384 + ksw(r, c)) = *(const bf16x8*)(kb + (size_t)(half * 128 + r) * 64 + c * 8);
        }
      }
      int lq = lane;
      asm volatile("" : "+v"(lq));
#pragma unroll
      for (int hh = 0; hh < 2; ++hh) {
        if (wr == hh) {
#pragma unroll
          for (int nt = 0; nt < 4; ++nt)
#pragma unroll
            for (int mt = 0; mt < 8; ++mt) {
              const int m_ = mt * 16 + (lq & 15);
              const int n_ = wc * 64 + nt * 16 + (lq >> 4) * 4;
              uint2 pk; pk.x = pack2bf(acc[nt][mt][0], acc[nt][mt][1]); pk.y = pack2bf(acc[nt][mt][2], acc[nt][mt][3]);
              *(uint2*)(QL + m_ * 256 + (((n_ >> 3) ^ (m_ & 15)) << 4) + (n_ & 4) * 2) = pk;
            }
        }
        __syncthreads();
        topk_tile(p, QL, KL, (unsigned char*)(smem + 65536) + w * 1024, bm + hh * 128, bn >> 7, lane, w);
        __syncthreads();
      }
    } else {
    float* ST = (float*)smem;
    int te = tid;
    asm volatile("" : "+v"(te));
    const int le = te & 63;
#pragma unroll
    for (int hseg = 0; hseg < 4; ++hseg) {
      if (wr == (hseg >> 1)) {
#pragma unroll
        for (int nt = 0; nt < 4; ++nt)
#pragma unroll
          for (int mt = 0; mt < 4; ++mt)
            *(float4*)&ST[(mt * 16 + (le & 15)) * 132 + wc * 64 + nt * 16 + (le >> 4) * 4] =
                make_float4(acc[nt][(hseg & 1) * 4 + mt][0], acc[nt][(hseg & 1) * 4 + mt][1], acc[nt][(hseg & 1) * 4 + mt][2], acc[nt][(hseg & 1) * 4 + mt][3]);
      }
      float xq[4][8];
      float4 gqa_[4], gqb_[4];
      if (EPI == 1) {
#pragma unroll
        for (int i = 0; i < 4; ++i) {
          const int e = i * 256 + te;
          const int m = bm + hseg * 64 + (e >> 4), n = bn + (e & 15) * 8;
          const float* g1 = p.MOD + ((size_t)l * NCOND + cond_of(m)) * 6144 + 2048 + n;
          if (l == 0) {
            const float* xr = m < TCTX ? p.in.x_prompt + (size_t)m * D : p.in.x_sample + (size_t)(m - TCTX) * D;
            ld8(xr + n, xq[i]);
          } else {
            ld8b(p.Xb + (size_t)m * D + n, xq[i]);
          }
          gqa_[i] = *(const float4*)g1; gqb_[i] = *(const float4*)(g1 + 4);
        }
      }
      __syncthreads();
#pragma unroll
      for (int i = 0; i < 4; ++i) {
        const int e = i * 256 + te;
        const int row = e >> 4, cc = (e & 15) * 8;
        const int m = bm + hseg * 64 + row, n = bn + cc;
        float4 v0 = *(const float4*)&ST[row * 132 + cc], v1 = *(const float4*)&ST[row * 132 + cc + 4];
        if (EPI == 0) {
          *(uint4*)&Cb[(size_t)m * N + n] = make_uint4(pack2bf(v0.x, v0.y), pack2bf(v0.z, v0.w), pack2bf(v1.x, v1.y), pack2bf(v1.z, v1.w));
          if (m < TCTX && n >= C_KA && n < C_UB) {
            size_t oo = ((size_t)((m >> 8) * DEPTH + l) * 256 + (m & 255)) * 256;
            float* dst = n < C_VA ? &p.out[O_NK + oo + (n - C_KA)] : &p.out[O_NV + oo + (n - C_VA)];
            *(float4*)dst = v0; *(float4*)(dst + 4) = v1;
          }
        } else {
          const float* xv = xq[i];
          const float4 ga = gqa_[i], gb = gqb_[i];
          *(uint4*)&p.MIXb[(size_t)m * N + n] = make_uint4(
              pack2bf(ALPHA * xv[0] + ga.x * v0.x, ALPHA * xv[1] + ga.y * v0.y), pack2bf(ALPHA * xv[2] + ga.z * v0.z, ALPHA * xv[3] + ga.w * v0.w),
              pack2bf(ALPHA * xv[4] + gb.x * v1.x, ALPHA * xv[5] + gb.y * v1.y), pack2bf(ALPHA * xv[6] + gb.z * v1.z, ALPHA * xv[7] + gb.w * v1.w));
        }
      }
      __syncthreads();
    }
    }
  }
}

using s16x4 = __attribute__((ext_vector_type(4))) short;
__device__ __forceinline__ bf16x8 pack8(const float* v) {
  bf16x8 o;
#pragma unroll
  for (int j = 0; j < 8; ++j) o[j] = (short)f2bf(v[j]);
  return o;
}
__device__ __forceinline__ void ks_write(char* KS, int tid, const float* v) {
  int row = tid >> 2, cp = tid & 3;
  *(bf16x8*)(KS + ksw(row, cp * 2)) = pack8(v);
  *(bf16x8*)(KS + ksw(row, cp * 2 + 1)) = pack8(v + 8);
}
constexpr int VTS = 68;
__device__ __forceinline__ void vt_write(bf16_t* VT, int tid, const float* v) {
  int row = tid & 63, cc = (tid >> 6) * 16;
#pragma unroll
  for (int i = 0; i < 16; ++i) VT[(cc + i) * VTS + row] = f2bf(v[i]);
}
__device__ __forceinline__ bf16x8 vt_frag_perm(const bf16_t* VT, int r, int ks, int g) {
  s16x4 lo = *(const s16x4*)(VT + r * VTS + 32 * ks + 4 * g);
  s16x4 hi = *(const s16x4*)(VT + r * VTS + 32 * ks + 16 + 4 * g);
  return __builtin_shufflevector(lo, hi, 0, 1, 2, 3, 4, 5, 6, 7);
}
__device__ __forceinline__ bf16x8 vt_frag_nat(const bf16_t* VT, int r, int ks, int g) {
  s16x4 lo = *(const s16x4*)(VT + r * VTS + 32 * ks + 8 * g);
  s16x4 hi = *(const s16x4*)(VT + r * VTS + 32 * ks + 8 * g + 4);
  return __builtin_shufflevector(lo, hi, 0, 1, 2, 3, 4, 5, 6, 7);
}
__device__ __forceinline__ bf16x8 pack_pt(const f32x4& a, const f32x4& b) {
  bf16x8 o;
  o[0] = (short)f2bf(a[0]); o[1] = (short)f2bf(a[1]); o[2] = (short)f2bf(a[2]); o[3] = (short)f2bf(a[3]);
  o[4] = (short)f2bf(b[0]); o[5] = (short)f2bf(b[1]); o[6] = (short)f2bf(b[2]); o[7] = (short)f2bf(b[3]);
  return o;
}
#define MFMA16(a, b, c) __builtin_amdgcn_mfma_f32_16x16x32_bf16((a), (b), (c), 0, 0, 0)
#define EXP2(x) __builtin_amdgcn_exp2f(x)

__device__ void attn_phase(const P& p, int l, char* smem, const int g_wbase) {
  const In& in = p.in;
  const bf16_t* Z = p.Z;
  char* KS0 = smem;
  bf16_t* VT0 = (bf16_t*)(smem + 16384);
  const int tid = otid(g_wbase), lane = tid & 63, w = tid >> 6, g = lane >> 4, li = lane & 15;
  const float* lp = in.diff_lambda + l * 128;
  float s01 = 0.f, s23 = 0.f;
  for (int i = 0; i < 32; ++i) { s01 += lp[i] * lp[32 + i]; s23 += lp[64 + i] * lp[96 + i]; }
  const float lmi = lam_init(l);
  const float lam = expf(s01) - expf(s23) + lmi;
  const float QSCALE = 0.17677669529663687f * 1.4426950408889634f;
  FOR_VB(512) {
    const bool lat = vb < 256;
    int seq, h, qb;
    if (lat) {
      const int grp = (vb & 7) * 4 + (vb >> 6), q8 = (vb >> 3) & 7;
      seq = grp >> 2; h = grp & 3; qb = q8;
    }
    else { int r = vb - 256; seq = r >> 3; h = (r >> 1) & 3; qb = r & 1; }
    const int tbase = lat ? TCTX + seq * 1024 : seq * 256;
    const int nkeys = lat ? 1536 : 256;
    bf16x8 qf[2][2];
#pragma unroll
    for (int c = 0; c < 2; ++c) {
      const int n = qb * 128 + w * 32 + c * 16 + li;
      const bf16_t* qrow = Z + (size_t)(tbase + n) * INW + C_QA + h * 64;
#pragma unroll
      for (int pp = 0; pp < 2; ++pp) {
        float x[8];
        ld8b(qrow + pp * 32 + 8 * g, x);
        if (lat) {
          float y[8];
          ld8b(qrow + pp * 32 + 8 * (g ^ 1), y);
          const int pos = (g < 2) ? (n >> 6) : (n & 63);
          const bool first = !(g & 1);
#pragma unroll
          for (int j = 0; j < 8; ++j) {
            float2 cs = p.ROPE[pos * 8 + j];
            x[j] = first ? x[j] * cs.x - y[j] * cs.y : x[j] * cs.x + y[j] * cs.y;
          }
        }
#pragma unroll
        for (int j = 0; j < 8; ++j) x[j] *= QSCALE;
        qf[pp][c] = pack8(x);
      }
    }
    uint4 rk0, rk1, rv0, rv1, sk0, sk1, sv0, sv1;
#define ATT_FETCH_K(kt0, rk0, rk1)                                                                 \
    {                                                                                    \
      const int j_ = (kt0) + (tid >> 2), cp_ = tid & 3;                                  \
      const bf16_t* s_;                                                                  \
      if (!lat) s_ = Z + (size_t)(tbase + j_) * INW + C_KA + h * 64 + cp_ * 16;          \
      else if ((kt0) < 512) s_ = p.CKb + ((size_t)((seq * DEPTH + l) * 512 + j_) * 4 + h) * 64 + cp_ * 16; \
      else s_ = Z + (size_t)(tbase + j_ - 512) * INW + C_KA + h * 64 + cp_ * 16;         \
      rk0 = *(const uint4*)s_; rk1 = *(const uint4*)(s_ + 8);                            \
    }
#define ATT_FETCH_V(kt0, rv0, rv1)                                                                 \
    {                                                                                    \
      const int j_ = (kt0) + (tid & 63), cc_ = (tid >> 6) * 16;                          \
      const bf16_t* s_;                                                                  \
      if (!lat) s_ = Z + (size_t)(tbase + j_) * INW + C_VA + h * 64 + cc_;               \
      else if ((kt0) < 512) s_ = p.CVb + ((size_t)((seq * DEPTH + l) * 512 + j_) * 4 + h) * 64 + cc_; \
      else s_ = Z + (size_t)(tbase + j_ - 512) * INW + C_VA + h * 64 + cc_;              \
      rv0 = *(const uint4*)s_; rv1 = *(const uint4*)(s_ + 8);                            \
    }
#define UNPK16(R0, R1, V)                                                                \
    V[0] = bflo(R0.x); V[1] = bfhi(R0.x); V[2] = bflo(R0.y); V[3] = bfhi(R0.y); V[4] = bflo(R0.z); V[5] = bfhi(R0.z); V[6] = bflo(R0.w); V[7] = bfhi(R0.w); \
    V[8] = bflo(R1.x); V[9] = bfhi(R1.x); V[10] = bflo(R1.y); V[11] = bfhi(R1.y); V[12] = bflo(R1.z); V[13] = bfhi(R1.z); V[14] = bflo(R1.w); V[15] = bfhi(R1.w);
#define ATT_COMMIT_K(kt0, rk0, rk1, KS)                                                                \
    {                                                                                    \
      if (lat && (kt0) >= 512) {                                                         \
        float v_[16];                                                                    \
        UNPK16(rk0, rk1, v_)                                                             \
        const int n_ = (kt0) + (tid >> 2) - 512;                                         \
        const int pos_ = (tid & 1) ? (n_ & 63) : (n_ >> 6);                              \
        _Pragma("unroll") for (int i_ = 0; i_ < 8; ++i_) {                               \
          float2 cs_ = p.ROPE[pos_ * 8 + i_];                                            \
          float x1_ = v_[i_], x2_ = v_[8 + i_];                                          \
          v_[i_] = x1_ * cs_.x - x2_ * cs_.y;                                            \
          v_[8 + i_] = x2_ * cs_.x + x1_ * cs_.y;                                        \
        }                                                                                \
        ks_write(KS, tid, v_);                                                           \
      } else {                                                                           \
        const int row_ = tid >> 2, cp_ = tid & 3;                                        \
        *(uint4*)(KS + ksw(row_, cp_ * 2)) = rk0;                                        \
        *(uint4*)(KS + ksw(row_, cp_ * 2 + 1)) = rk1;                                    \
      }                                                                                  \
    }
#define ATT_COMMIT_V(rv0, rv1, VT)                                                                   \
    {                                                                                    \
      const int row_ = tid & 63, cc_ = (tid >> 6) * 16;                                  \
      const unsigned w_[8] = {rv0.x, rv0.y, rv0.z, rv0.w, rv1.x, rv1.y, rv1.z, rv1.w};   \
      _Pragma("unroll") for (int i_ = 0; i_ < 8; ++i_) {                                 \
        VT[(cc_ + 2 * i_) * VTS + row_] = (bf16_t)(w_[i_] & 0xffffu);                    \
        VT[(cc_ + 2 * i_ + 1) * VTS + row_] = (bf16_t)(w_[i_] >> 16);                    \
      }                                                                                  \
    }
    float mx[2][2];
#pragma unroll
    for (int a = 0; a < 2; ++a)
#pragma unroll
      for (int b = 0; b < 2; ++b) mx[a][b] = -1e30f;
    ATT_FETCH_K(0, rk0, rk1)
    ATT_FETCH_K(64, sk0, sk1)
    for (int kt0 = 0; kt0 < nkeys; kt0 += 128) {
      __syncthreads();
      ATT_COMMIT_K(kt0, rk0, rk1, KS0)
      ATT_COMMIT_K(kt0 + 64, sk0, sk1, (KS0 + 8192))
      __syncthreads();
      if (kt0 + 128 < nkeys) { ATT_FETCH_K(kt0 + 128, rk0, rk1) ATT_FETCH_K(kt0 + 192, sk0, sk1) }
#pragma unroll
      for (int hk = 0; hk < 2; ++hk) {
      const char* KS = KS0 + hk * 8192;
#pragma unroll
      for (int pp = 0; pp < 2; ++pp) {
        f32x4 st[4][2];
#pragma unroll
        for (int kt = 0; kt < 4; ++kt) {
          bf16x8 kf = *(const bf16x8*)(KS + ksw(kt * 16 + li, pp * 4 + g));
#pragma unroll
          for (int c = 0; c < 2; ++c) st[kt][c] = MFMA16(kf, qf[pp][c], (f32x4{0.f, 0.f, 0.f, 0.f}));
        }
#pragma unroll
        for (int c = 0; c < 2; ++c) {
          float tm = mx[pp][c];
#pragma unroll
          for (int kt = 0; kt < 4; ++kt) {
            tm = fmaxf(fmaxf(tm, st[kt][c][0]), st[kt][c][1]);
            tm = fmaxf(fmaxf(tm, st[kt][c][2]), st[kt][c][3]);
          }
          mx[pp][c] = tm;
        }
      }
      }
    }
#pragma unroll
    for (int pp = 0; pp < 2; ++pp)
#pragma unroll
      for (int c = 0; c < 2; ++c) {
        float m0 = mx[pp][c];
        m0 = fmaxf(m0, shx(m0, 16));
        m0 = fmaxf(m0, shx(m0, 32));
        mx[pp][c] = -m0;
      }
    f32x4 o1[4][2], o2[4][2], ol1[2], ol2[2];
#pragma unroll
    for (int c = 0; c < 2; ++c) {
      ol1[c] = f32x4{0.f, 0.f, 0.f, 0.f}; ol2[c] = f32x4{0.f, 0.f, 0.f, 0.f};
#pragma unroll
      for (int dt = 0; dt < 4; ++dt) { o1[dt][c] = f32x4{0.f, 0.f, 0.f, 0.f}; o2[dt][c] = f32x4{0.f, 0.f, 0.f, 0.f}; }
    }
    bf16x8 ones;
#pragma unroll
    for (int j = 0; j < 8; ++j) ones[j] = (short)0x3F80;
    ATT_FETCH_K(0, rk0, rk1)
    ATT_FETCH_V(0, rv0, rv1)
    ATT_FETCH_K(64, sk0, sk1)
    ATT_FETCH_V(64, sv0, sv1)
    for (int kt0 = 0; kt0 < nkeys; kt0 += 128) {
      __syncthreads();
      ATT_COMMIT_K(kt0, rk0, rk1, KS0)
      ATT_COMMIT_V(rv0, rv1, VT0)
      ATT_COMMIT_K(kt0 + 64, sk0, sk1, (KS0 + 8192))
      ATT_COMMIT_V(sv0, sv1, (VT0 + 64 * VTS))
      __syncthreads();
      if (kt0 + 128 < nkeys) {
        int tid_o = tid;
        asm volatile("" : "+v"(tid_o));
        const int tid = tid_o;
        ATT_FETCH_K(kt0 + 128, rk0, rk1) ATT_FETCH_V(kt0 + 128, rv0, rv1) ATT_FETCH_K(kt0 + 192, sk0, sk1) ATT_FETCH_V(kt0 + 192, sv0, sv1)
      }
#pragma unroll
      for (int hk = 0; hk < 2; ++hk) {
      const char* KS = KS0 + hk * 8192;
      const bf16_t* VT = VT0 + hk * 64 * VTS;
#pragma unroll
      for (int ks = 0; ks < 2; ++ks) {
        bf16x8 pb1[2], pb2[2];
        {
          f32x4 p1[2][2], p2[2][2];
#pragma unroll
          for (int kk = 0; kk < 2; ++kk) {
            const int kt = 2 * ks + kk;
            bf16x8 k1 = *(const bf16x8*)(KS + ksw(kt * 16 + li, g));
            bf16x8 k2 = *(const bf16x8*)(KS + ksw(kt * 16 + li, 4 + g));
#pragma unroll
            for (int c = 0; c < 2; ++c) {
              f32x4 s1 = MFMA16(k1, qf[0][c], (f32x4{mx[0][c], mx[0][c], mx[0][c], mx[0][c]}));
              f32x4 s2 = MFMA16(k2, qf[1][c], (f32x4{mx[1][c], mx[1][c], mx[1][c], mx[1][c]}));
#pragma unroll
              for (int r = 0; r < 4; ++r) { p1[kk][c][r] = EXP2(s1[r]); p2[kk][c][r] = EXP2(s2[r]); }
            }
          }
#pragma unroll
          for (int c = 0; c < 2; ++c) { pb1[c] = pack_pt(p1[0][c], p1[1][c]); pb2[c] = pack_pt(p2[0][c], p2[1][c]); }
        }
#pragma unroll
        for (int c = 0; c < 2; ++c) { ol1[c] = MFMA16(ones, pb1[c], ol1[c]); ol2[c] = MFMA16(ones, pb2[c], ol2[c]); }
#pragma unroll
        for (int dt = 0; dt < 4; ++dt) {
          bf16x8 vf = vt_frag_perm(VT, dt * 16 + li, ks, g);
#pragma unroll
          for (int c = 0; c < 2; ++c) { o1[dt][c] = MFMA16(vf, pb1[c], o1[dt][c]); o2[dt][c] = MFMA16(vf, pb2[c], o2[dt][c]); }
        }
      }
      }
    }
    f32x4 o[4][2];
#pragma unroll
    for (int c = 0; c < 2; ++c) {
      const float i1 = 1.f / ol1[c][0], i2 = lam / ol2[c][0];
#pragma unroll
      for (int dt = 0; dt < 4; ++dt)
#pragma unroll
        for (int r = 0; r < 4; ++r) o[dt][c][r] = o1[dt][c][r] * i1 - o2[dt][c][r] * i2;
    }
    float4 ggv[4];
    {
      int lg_ = lane;
      asm volatile("" : "+v"(lg_));
#pragma unroll
      for (int dt = 0; dt < 4; ++dt) ggv[dt] = *(const float4*)(in.diff_subln_g + l * 64 + dt * 16 + 4 * (lg_ >> 4));
    }
#pragma unroll
    for (int c = 0; c < 2; ++c) {
      float ss = 0.f;
#pragma unroll
      for (int dt = 0; dt < 4; ++dt)
#pragma unroll
        for (int r = 0; r < 4; ++r) ss += o[dt][c][r] * o[dt][c][r];
      ss += shx(ss, 16);
      ss += shx(ss, 32);
      const float rr = rsqrtf(ss * (1.f / 64.f) + LN_EPS) * (1.f - lmi);
      int le_ = lane;
      asm volatile("" : "+v"(le_));
      const int n = qb * 128 + w * 32 + c * 16 + (le_ & 15);
#pragma unroll
      for (int dt = 0; dt < 4; ++dt) {
        const int dv = dt * 16 + 4 * (le_ >> 4);
        uint2 pk;
        pk.x = pack2bf(o[dt][c][0] * rr * ggv[dt].x, o[dt][c][1] * rr * ggv[dt].y);
        pk.y = pack2bf(o[dt][c][2] * rr * ggv[dt].z, o[dt][c][3] * rr * ggv[dt].w);
        *(uint2*)&p.MIXCATb[(size_t)(tbase + n) * D + h * 64 + dv] = pk;
      }
    }
  }
}

__device__ void ret_phase(const P& p, int l, char* smem, const int g_wbase) {
  const In& in = p.in;
  const bf16_t* Z = p.Z;
  char* KS = smem;
  bf16_t* VT = (bf16_t*)(smem + 8192);
  bf16_t* VT2 = (bf16_t*)(smem + 8192 + 8704);
  const int tid = otid(g_wbase), lane = tid & 63, w = tid >> 6, g = lane >> 4, li = lane & 15;
  FOR_VB(512) {
    const int it = (vb + 256) & 511;
    const bool lat = it < 256;
    int seq, h, qb;
    if (lat) { const int grp = (it & 7) * 4 + (it >> 6), q8 = (it >> 3) & 7; seq = grp >> 2; h = grp & 3; qb = q8; }
    else { int r = it - 256; seq = r >> 3; h = (r >> 1) & 3; qb = r & 1; }
    const int tbase = lat ? TCTX + seq * 1024 : seq * 256;
    const int nlen = lat ? 1024 : 256;
    const float lgf = -log1pf(expf(-in.ret_decay[(l * 2 + 0) * 4 + h])) * 1.4426950408889634f;
    const float lgb = -log1pf(expf(-in.ret_decay[(l * 2 + 1) * 4 + h])) * 1.4426950408889634f;
    bf16x8 qf[2][2];
#pragma unroll
    for (int c = 0; c < 2; ++c) {
      const int n = qb * 128 + w * 32 + c * 16 + li;
      const bf16_t* qrow = Z + (size_t)(tbase + n) * INW + C_QC + h * 64;
#pragma unroll
      for (int ks = 0; ks < 2; ++ks) {
        float x[8];
        ld8b(qrow + ks * 32 + 8 * g, x);
        qf[ks][c] = pack8(x);
      }
    }
    f32x4 o[4][2];
#pragma unroll
    for (int dt = 0; dt < 4; ++dt)
#pragma unroll
      for (int c = 0; c < 2; ++c) o[dt][c] = f32x4{0.f, 0.f, 0.f, 0.f};
    if (lat) {
      __syncthreads();
      {
        const float* s0f = in.state_ret + ((size_t)((seq * DEPTH + l) * 2 + 0) * 4 + h) * 4096;
        const float* s0b = in.state_ret + ((size_t)((seq * DEPTH + l) * 2 + 1) * 4 + h) * 4096;
        float v[16];
        ld16(s0f + (tid & 63) * 64 + (tid >> 6) * 16, v);
        vt_write(VT, tid, v);
        ld16(s0b + (tid & 63) * 64 + (tid >> 6) * 16, v);
        vt_write(VT2, tid, v);
      }
      __syncthreads();
#pragma unroll
      for (int dir = 0; dir < 2; ++dir) {
        const bf16_t* ST = dir ? VT2 : VT;
        f32x4 tmp[4][2];
#pragma unroll
        for (int dt = 0; dt < 4; ++dt)
#pragma unroll
          for (int c = 0; c < 2; ++c) tmp[dt][c] = f32x4{0.f, 0.f, 0.f, 0.f};
#pragma unroll
        for (int ks = 0; ks < 2; ++ks)
#pragma unroll
          for (int dt = 0; dt < 4; ++dt) {
            bf16x8 af = vt_frag_nat(ST, dt * 16 + li, ks, g);
#pragma unroll
            for (int c = 0; c < 2; ++c) tmp[dt][c] = MFMA16(af, qf[ks][c], tmp[dt][c]);
          }
#pragma unroll
        for (int c = 0; c < 2; ++c) {
          const int n = qb * 128 + w * 32 + c * 16 + li;
          const float sc = dir ? EXP2(lgb * (float)(nlen - n)) : EXP2(lgf * (float)(n + 1));
#pragma unroll
          for (int dt = 0; dt < 4; ++dt)
#pragma unroll
            for (int r = 0; r < 4; ++r) o[dt][c][r] += sc * tmp[dt][c][r];
        }
      }
    }
    uint4 rk0, rk1, rv0, rv1;
#define RET_FETCH(kt0)                                                                   \
    {                                                                                    \
      const bf16_t* sk_ = Z + (size_t)(tbase + (kt0) + (tid >> 2)) * INW + C_KC + h * 64 + (tid & 3) * 16; \
      const bf16_t* sv_ = Z + (size_t)(tbase + (kt0) + (tid & 63)) * INW + C_VC + h * 64 + (tid >> 6) * 16; \
      rk0 = *(const uint4*)sk_; rk1 = *(const uint4*)(sk_ + 8);                          \
      rv0 = *(const uint4*)sv_; rv1 = *(const uint4*)(sv_ + 8);                          \
    }
    RET_FETCH(0)
    for (int kt0 = 0; kt0 < nlen; kt0 += 64) {
      __syncthreads();
      {
        const int row_ = tid >> 2, cp_ = tid & 3;
        *(uint4*)(KS + ksw(row_, cp_ * 2)) = rk0;
        *(uint4*)(KS + ksw(row_, cp_ * 2 + 1)) = rk1;
        const int vrow_ = tid & 63, cc_ = (tid >> 6) * 16;
        const unsigned w_[8] = {rv0.x, rv0.y, rv0.z, rv0.w, rv1.x, rv1.y, rv1.z, rv1.w};
#pragma unroll
        for (int i_ = 0; i_ < 8; ++i_) {
          VT[(cc_ + 2 * i_) * VTS + vrow_] = (bf16_t)(w_[i_] & 0xffffu);
          VT[(cc_ + 2 * i_ + 1) * VTS + vrow_] = (bf16_t)(w_[i_] >> 16);
        }
      }
      __syncthreads();
      if (kt0 + 64 < nlen) RET_FETCH(kt0 + 64)
      f32x4 pt[4][2];
#pragma unroll
      for (int kt = 0; kt < 4; ++kt) {
        bf16x8 k1 = *(const bf16x8*)(KS + ksw(kt * 16 + li, g));
        bf16x8 k2 = *(const bf16x8*)(KS + ksw(kt * 16 + li, 4 + g));
#pragma unroll
        for (int c = 0; c < 2; ++c) {
          f32x4 s = MFMA16(k1, qf[0][c], (f32x4{0.f, 0.f, 0.f, 0.f}));
          s = MFMA16(k2, qf[1][c], s);
          const int tq = qb * 128 + w * 32 + c * 16 + li;
#pragma unroll
          for (int r = 0; r < 4; ++r) {
            const int sk = kt0 + kt * 16 + 4 * g + r;
            const int rel = tq - sk;
            float dec = rel > 0 ? EXP2(lgf * (float)rel) : (rel < 0 ? EXP2(lgb * (float)(-rel)) : 2.f);
            pt[kt][c][r] = s[r] * dec * 0.125f;
          }
        }
      }
#pragma unroll
      for (int ks = 0; ks < 2; ++ks) {
        bf16x8 pb[2];
#pragma unroll
        for (int c = 0; c < 2; ++c) pb[c] = pack_pt(pt[2 * ks][c], pt[2 * ks + 1][c]);
#pragma unroll
        for (int dt = 0; dt < 4; ++dt) {
          bf16x8 vf = vt_frag_perm(VT, dt * 16 + li, ks, g);
#pragma unroll
          for (int c = 0; c < 2; ++c) o[dt][c] = MFMA16(vf, pb[c], o[dt][c]);
        }
      }
    }
    uint2 gqa[2][4];
#pragma unroll
    for (int c = 0; c < 2; ++c)
#pragma unroll
      for (int dt = 0; dt < 4; ++dt)
        gqa[c][dt] = *(const uint2*)&Z[(size_t)(tbase + qb * 128 + w * 32 + c * 16 + li) * INW + C_GC + h * 64 + dt * 16 + 4 * g];
#pragma unroll
    for (int c = 0; c < 2; ++c) {
      float s = 0.f;
#pragma unroll
      for (int dt = 0; dt < 4; ++dt)
#pragma unroll
        for (int r = 0; r < 4; ++r) s += o[dt][c][r];
      s += shx(s, 16);
      s += shx(s, 32);
      const float mu = s * (1.f / 64.f);
      float sq = 0.f;
#pragma unroll
      for (int dt = 0; dt < 4; ++dt)
#pragma unroll
        for (int r = 0; r < 4; ++r) { float d = o[dt][c][r] - mu; sq += d * d; }
      sq += shx(sq, 16);
      sq += shx(sq, 32);
      const float rr = rsqrtf(sq * (1.f / 64.f) + LN_EPS);
      const int n = qb * 128 + w * 32 + c * 16 + li;
#pragma unroll
      for (int dt = 0; dt < 4; ++dt) {
        const int dv = dt * 16 + 4 * g;
        const uint2 gq = gqa[c][dt];
        uint2 pk;
        pk.x = pack2bf((o[dt][c][0] - mu) * rr * silu_f(bflo(gq.x)), (o[dt][c][1] - mu) * rr * silu_f(bfhi(gq.x)));
        pk.y = pack2bf((o[dt][c][2] - mu) * rr * silu_f(bflo(gq.y)), (o[dt][c][3] - mu) * rr * silu_f(bfhi(gq.y)));
        *(uint2*)&p.MIXCATb[(size_t)(tbase + n) * D + 512 + h * 64 + dv] = pk;
      }
    }
  }
}

__device__ void ret_state_phase(const P& p, int l, char* smem, const int g_wbase) {
  const In& in = p.in;
  const bf16_t* Z = p.Z;
  bf16_t* KTF = (bf16_t*)smem;
  bf16_t* KTB = (bf16_t*)(smem + 8704);
  bf16_t* VT = (bf16_t*)(smem + 2 * 8704);
  const int tid = otid(g_wbase), lane = tid & 63, w = tid >> 6, g = lane >> 4, li = lane & 15;
  FOR_VB(128) {
    const int seq = vb >> 2, h = vb & 3;
    const int tbase = seq * 256;
    const float lgf = -log1pf(expf(-in.ret_decay[(l * 2 + 0) * 4 + h])) * 1.4426950408889634f;
    const float lgb = -log1pf(expf(-in.ret_decay[(l * 2 + 1) * 4 + h])) * 1.4426950408889634f;
    f32x4 af[4], ab[4];
#pragma unroll
    for (int vt = 0; vt < 4; ++vt) { af[vt] = f32x4{0.f, 0.f, 0.f, 0.f}; ab[vt] = f32x4{0.f, 0.f, 0.f, 0.f}; }
    uint4 kr[4][2], vr[4][2];
#pragma unroll
    for (int st = 0; st < 4; ++st) {
      const bf16_t* zk = Z + (size_t)(tbase + st * 64 + (tid & 63)) * INW + h * 64 + (tid >> 6) * 16;
      kr[st][0] = *(const uint4*)(zk + C_KC); kr[st][1] = *(const uint4*)(zk + C_KC + 8);
      vr[st][0] = *(const uint4*)(zk + C_VC); vr[st][1] = *(const uint4*)(zk + C_VC + 8);
    }
#pragma unroll
    for (int st = 0; st < 4; ++st) {
      const int kt0 = st * 64;
      __syncthreads();
      {
        const int s = kt0 + (tid & 63);
        float v[16], u[16];
        {
          const unsigned rw_[8] = {kr[st][0].x, kr[st][0].y, kr[st][0].z, kr[st][0].w, kr[st][1].x, kr[st][1].y, kr[st][1].z, kr[st][1].w};
#pragma unroll
          for (int q = 0; q < 8; ++q) { v[2 * q] = bflo(rw_[q]); v[2 * q + 1] = bfhi(rw_[q]); }
        }
        const float df = EXP2(lgf * (float)(255 - s)) * 0.125f, db = EXP2(lgb * (float)s) * 0.125f;
#pragma unroll
        for (int i = 0; i < 16; ++i) u[i] = v[i] * df;
        vt_write(KTF, tid, u);
#pragma unroll
        for (int i = 0; i < 16; ++i) u[i] = v[i] * db;
        vt_write(KTB, tid, u);
        {
          const unsigned rw_[8] = {vr[st][0].x, vr[st][0].y, vr[st][0].z, vr[st][0].w, vr[st][1].x, vr[st][1].y, vr[st][1].z, vr[st][1].w};
#pragma unroll
          for (int q = 0; q < 8; ++q) { v[2 * q] = bflo(rw_[q]); v[2 * q + 1] = bfhi(rw_[q]); }
        }
        vt_write(VT, tid, v);
      }
      __syncthreads();
#pragma unroll
      for (int ks = 0; ks < 2; ++ks) {
        bf16x8 kf = vt_frag_nat(KTF, w * 16 + li, ks, g);
        bf16x8 kb = vt_frag_nat(KTB, w * 16 + li, ks, g);
#pragma unroll
        for (int vt = 0; vt < 4; ++vt) {
          bf16x8 vf = vt_frag_nat(VT, vt * 16 + li, ks, g);
          af[vt] = MFMA16(kf, vf, af[vt]);
          ab[vt] = MFMA16(kb, vf, ab[vt]);
        }
      }
    }
    float* sf = p.out + O_NS + ((size_t)((seq * DEPTH + l) * 2 + 0) * 4 + h) * 4096;
    float* sb = p.out + O_NS + ((size_t)((seq * DEPTH + l) * 2 + 1) * 4 + h) * 4096;
#pragma unroll
    for (int vt = 0; vt < 4; ++vt)
#pragma unroll
      for (int r = 0; r < 4; ++r) {
        const int d = w * 16 + 4 * g + r, v = vt * 16 + li;
        sf[d * 64 + v] = af[vt][r];
        sb[d * 64 + v] = ab[vt][r];
      }
  }
}


__device__ void cacheconv_phase(const P& p) {
  const size_t n8 = (size_t)8 * DEPTH * 512 * 256 / 8;
  for (size_t i = (size_t)blockIdx.x * 256 + threadIdx.x; i < 2 * n8; i += (size_t)gridDim.x * 256) {
    const float* s = i < n8 ? p.in.cache_k + i * 8 : p.in.cache_v + (i - n8) * 8;
    bf16_t* d = i < n8 ? p.CKb + i * 8 : p.CVb + (i - n8) * 8;
    float4 a = *(const float4*)s, b = *(const float4*)(s + 4);
    *(uint4*)d = make_uint4(pack2bf(a.x, a.y), pack2bf(a.z, a.w), pack2bf(b.x, b.y), pack2bf(b.z, b.w));
  }
}
__device__ void keysconv_phase(const P& p) {
  for (int i = blockIdx.x * 256 + threadIdx.x; i < DEPTH * 2 * 128 * 64; i += gridDim.x * 256) p.KEYSb[i] = f2bf(p.in.peer_keys[i]);
}

__device__ void gmlp_phase(const P& p, int l, char* smem, const int g_wbase) {
  const In& in = p.in;
  const bf16_t* Z = p.Z;
  char* WS = smem;
  bf16_t* VT = (bf16_t*)(smem + 32768);
  constexpr int VS = 136;
  const int tid = otid(g_wbase), lane = tid & 63, w = tid >> 6, g4 = lane >> 4, li = lane & 15;
  FOR_VB(512) {
    const int chunk = vb >> 2, g = vb & 3;
    const int t0 = chunk * 128;
    __syncthreads();
    {
      const float* ws = in.gmlp_ws + (size_t)(l * 4 + g) * 128 * 128;
#pragma unroll
      for (int i = 0; i < 8; ++i) {
        int e = i * 256 + tid;
        int row = e >> 4, c = e & 15;
        float v[8];
        ld8(ws + row * 128 + c * 8, v);
        *(bf16x8*)(WS + row * 256 + ((c ^ (row & 15)) << 4)) = pack8(v);
      }
    }
    {
      const int q = tid >> 1, half = tid & 1;
      const bf16_t* zr = Z + (size_t)(t0 + q) * INW + C_VB;
      float s = 0.f, sq = 0.f;
#pragma unroll 2
      for (int i = 0; i < 16; ++i) {
        float x[8];
        ld8b(zr + half * 128 + i * 8, x);
#pragma unroll
        for (int j = 0; j < 8; ++j) { float a = gelu_f(x[j]); s += a; sq += a * a; }
      }
      s += shx(s, 1);
      sq += shx(sq, 1);
      const float mu = s * (1.f / 256.f);
      const float var = fmaxf(sq * (1.f / 256.f) - mu * mu, 0.f);
      const float rr = rsqrtf(var + LN_EPS);
      const float* lg = in.gmlp_ln_g + l * 256 + g * 64 + half * 32;
      const float* lb = in.gmlp_ln_b + l * 256 + g * 64 + half * 32;
#pragma unroll 2
      for (int i = 0; i < 4; ++i) {
        float x[8];
        ld8b(zr + g * 64 + half * 32 + i * 8, x);
#pragma unroll
        for (int j = 0; j < 8; ++j)
          VT[(half * 32 + i * 8 + j) * VS + q] = f2bf((gelu_f(x[j]) - mu) * rr * lg[i * 8 + j] + lb[i * 8 + j]);
      }
    }
    __syncthreads();
    f32x4 acc[4][2];
#pragma unroll
    for (int dt = 0; dt < 4; ++dt)
#pragma unroll
      for (int pt = 0; pt < 2; ++pt) acc[dt][pt] = f32x4{0.f, 0.f, 0.f, 0.f};
#pragma unroll
    for (int ks = 0; ks < 4; ++ks) {
      bf16x8 bw[2];
#pragma unroll
      for (int pt = 0; pt < 2; ++pt) {
        int row = w * 32 + pt * 16 + li, c = ks * 4 + g4;
        bw[pt] = *(const bf16x8*)(WS + row * 256 + ((c ^ (row & 15)) << 4));
      }
#pragma unroll
      for (int dt = 0; dt < 4; ++dt) {
        const bf16_t* vr = VT + (dt * 16 + li) * VS + ks * 32 + g4 * 8;
        s16x4 lo = *(const s16x4*)vr, hi = *(const s16x4*)(vr + 4);
        bf16x8 av = __builtin_shufflevector(lo, hi, 0, 1, 2, 3, 4, 5, 6, 7);
#pragma unroll
        for (int pt = 0; pt < 2; ++pt) acc[dt][pt] = MFMA16(av, bw[pt], acc[dt][pt]);
      }
    }
    uint2 uqa[2][4];
    float bsa[2];
#pragma unroll
    for (int pt = 0; pt < 2; ++pt) {
      const int pp = w * 32 + pt * 16 + li;
      bsa[pt] = in.gmlp_bs[(l * 4 + g) * 128 + pp];
#pragma unroll
      for (int dt = 0; dt < 4; ++dt) uqa[pt][dt] = *(const uint2*)(Z + (size_t)(t0 + pp) * INW + C_UB + g * 64 + dt * 16 + 4 * g4);
    }
#pragma unroll
    for (int pt = 0; pt < 2; ++pt) {
      const int pp = w * 32 + pt * 16 + li;
      const float bs = bsa[pt];
#pragma unroll
      for (int dt = 0; dt < 4; ++dt) {
        const int d = dt * 16 + 4 * g4;
        const uint2 uq = uqa[pt][dt];
        uint2 pk;
        pk.x = pack2bf(gelu_f(bflo(uq.x)) * (acc[dt][pt][0] + bs), gelu_f(bfhi(uq.x)) * (acc[dt][pt][1] + bs));
        pk.y = pack2bf(gelu_f(bflo(uq.y)) * (acc[dt][pt][2] + bs), gelu_f(bfhi(uq.y)) * (acc[dt][pt][3] + bs));
        *(uint2*)&p.MIXCATb[(size_t)(t0 + pp) * D + 256 + g * 64 + d] = pk;
      }
    }
  }
}

__device__ void conv_fast_phase(const P& p, int l, char* smem, const int g_wbase) {
  const In& in = p.in;
  const bf16_t* Z = p.Z;
  float* Y = (float*)smem;
  const int tid = otid(g_wbase), lane = tid & 63, w = tid >> 6;
  const int ch = tid;
  float wgt[31];
#pragma unroll
  for (int j = 0; j < 31; ++j) wgt[j] = in.conv_w[((size_t)l * 31 + j) * 256 + ch];
  const float bias = in.conv_b[l * 256 + ch];
  FOR_VB(512) {
    const bool lat = vb >= 256;
    int seq, tile, len, tbase;
    if (!lat) { seq = vb >> 3; tile = vb & 7; len = 256; tbase = seq * 256; }
    else { int r = vb - 256; seq = r >> 5; tile = r & 31; len = 1024; tbase = TCTX + seq * 1024; }
    const int n0 = tile * 32;
    float acc[32];
#pragma unroll
    for (int n = 0; n < 32; ++n) acc[n] = bias;
#pragma unroll
    for (int r0 = 0; r0 < 64; r0 += 32) {
      bf16_t ra[32], rb[32];
#pragma unroll
      for (int k = 0; k < 32; ++k) {
        const int m = n0 - 15 + r0 + k;
        const int mc = min(max(m, 0), len - 1);
        const bf16_t* zr = Z + (size_t)(tbase + mc) * INW;
        ra[k] = zr[C_AD + ch]; rb[k] = zr[C_BD + ch];
      }
#pragma unroll
      for (int k = 0; k < 32; ++k) {
        const int r = r0 + k;
        if (r < 62) {
          const int m = n0 - 15 + r;
          const float hv = (m >= 0 && m < len) ? bf2f(ra[k]) * sigmoid_f(bf2f(rb[k])) : 0.f;
#pragma unroll
          for (int n = 0; n < 32; ++n) {
            const int j = r - n;
            if (j >= 0 && j < 31) acc[n] += wgt[j] * hv;
          }
        }
      }
    }
    __syncthreads();
#pragma unroll
    for (int n = 0; n < 32; ++n) Y[n * 256 + ch] = acc[n];
    __syncthreads();
    const float4 gg = *(const float4*)&in.conv_ln_g[l * 256 + lane * 4], bb = *(const float4*)&in.conv_ln_b[l * 256 + lane * 4];
#pragma unroll
    for (int i = 0; i < 8; ++i) {
      const int n = w * 8 + i;
      float4 y = *(const float4*)&Y[n * 256 + lane * 4];
      float mu = wave_sum_u((y.x + y.y) + (y.z + y.w)) * (1.f / 256.f);
      y.x -= mu; y.y -= mu; y.z -= mu; y.w -= mu;
      float rr = rsqrtf(wave_sum_u((y.x * y.x + y.y * y.y) + (y.z * y.z + y.w * y.w)) * (1.f / 256.f) + LN_EPS);
      uint2 pk;
      pk.x = pack2bf(silu_f(y.x * rr * gg.x + bb.x), silu_f(y.y * rr * gg.y + bb.y));
      pk.y = pack2bf(silu_f(y.z * rr * gg.z + bb.z), silu_f(y.w * rr * gg.w + bb.w));
      *(uint2*)&p.MIXCATb[(size_t)(tbase + n0 + n) * D + 768 + lane * 4] = pk;
    }
  }
}

__device__ void mod_fast_phase(const P& p, char* smem, const int g_wbase) {
  float* SC = (float*)smem;
  float* RED = (float*)smem + 9 * 1024;
  const int tid = otid(g_wbase), lane = tid & 63, w = tid >> 6;
  __syncthreads();
  for (int i = tid; i < 9 * 1024; i += 256) {
    int c = i >> 10, k = i & 1023;
    SC[i] = silu_f(c == 0 ? p.in.c_ctx[k] : p.in.c[(size_t)(c - 1) * D + k]);
  }
  __syncthreads();
  FOR_VB(DEPTH * 96) {
    const int l = vb / 96, n0 = (vb % 96) * 64;
    const int rg = lane >> 4, c4 = (lane & 15) * 4;
    const float* wp = p.in.w_mod + ((size_t)l * D + w * 256 + rg) * 6144 + n0 + c4;
    float a4[9][4];
#pragma unroll
    for (int c = 0; c < 9; ++c) { a4[c][0] = 0.f; a4[c][1] = 0.f; a4[c][2] = 0.f; a4[c][3] = 0.f; }
#pragma unroll 4
    for (int k = 0; k < 256; k += 4) {
      const float4 wv = *(const float4*)(wp + (size_t)k * 6144);
#pragma unroll
      for (int c = 0; c < 9; ++c) {
        const float sc = SC[c * 1024 + w * 256 + k + rg];
        a4[c][0] += sc * wv.x; a4[c][1] += sc * wv.y; a4[c][2] += sc * wv.z; a4[c][3] += sc * wv.w;
      }
    }
    const int pa16 = (lane ^ 16) << 2, pa32 = (lane ^ 32) << 2;
#pragma unroll
    for (int c = 0; c < 9; ++c)
#pragma unroll
      for (int j = 0; j < 4; ++j) {
        float v = a4[c][j];
        v += __int_as_float(__builtin_amdgcn_ds_bpermute(pa16, __float_as_int(v)));
        v += __int_as_float(__builtin_amdgcn_ds_bpermute(pa32, __float_as_int(v)));
        a4[c][j] = v;
      }
    __syncthreads();
    if (rg == 0) {
#pragma unroll
      for (int c = 0; c < 9; ++c) *(float4*)&RED[(w * 9 + c) * 64 + c4] = make_float4(a4[c][0], a4[c][1], a4[c][2], a4[c][3]);
    }
    __syncthreads();
    for (int i = tid; i < 9 * 64; i += 256) {
      int c = i >> 6, nn = i & 63;
      float s = RED[(0 * 9 + c) * 64 + nn] + RED[(1 * 9 + c) * 64 + nn] + RED[(2 * 9 + c) * 64 + nn] + RED[(3 * 9 + c) * 64 + nn];
      int ncol = (vb % 96) * 64 + nn;
      p.MOD[((size_t)l * NCOND + c) * 6144 + ncol] = s + p.in.b_mod[l * 6144 + ncol];
    }
  }
}

typedef float f32x2_t __attribute__((ext_vector_type(2)));
template <int CTRL, int ROWMASK>
__device__ __forceinline__ float dpp_max(float v) {
  int t = __builtin_amdgcn_update_dpp(__float_as_int(v), __float_as_int(v), CTRL, ROWMASK, 0xf, false);
  return fmaxf(v, __int_as_float(t));
}
__device__ __forceinline__ float wave_max_u(float v) {
  v = dpp_max<0xB1, 0xf>(v);
  v = dpp_max<0x4E, 0xf>(v);
  v = dpp_max<0x141, 0xf>(v);
  v = dpp_max<0x140, 0xf>(v);
  v = dpp_max<0x142, 0xa>(v);
  v = dpp_max<0x143, 0xc>(v);
  return __int_as_float(__builtin_amdgcn_readlane(__float_as_int(v), 63));
}
__device__ void tabconv8_phase(const P& p, const int g_wbase) {
  const int tid = otid(g_wbase), lane = tid & 63, w = tid >> 6;
  const int NR = DEPTH * 16384;
  const int stride = gridDim.x * 4;
  for (int r0 = blockIdx.x * 4 + w; r0 < 2 * NR; r0 += 2 * stride) {
    f32x4 v[2][4];
#pragma unroll
    for (int u = 0; u < 2; ++u) {
      const int r = r0 + u * stride;
      if (r < 2 * NR) {
        const bool isv = r >= NR;
        const int rr = isv ? r - NR : r;
        const float* s = (isv ? p.in.peer_v : p.in.peer_u) + (size_t)rr * D + lane * 16;
#pragma unroll
        for (int q = 0; q < 4; ++q) v[u][q] = __builtin_nontemporal_load((const f32x4*)s + q);
      }
    }
#pragma unroll
    for (int u = 0; u < 2; ++u) {
      const int r = r0 + u * stride;
      if (r < 2 * NR) {
        const bool isv = r >= NR;
        const int rr = isv ? r - NR : r;
        float m = 0.f;
#pragma unroll
        for (int q = 0; q < 4; ++q)
#pragma unroll
          for (int i = 0; i < 4; ++i) m = fmaxf(m, fabsf(v[u][q][i]));
        m = wave_max_u(m);
        const float sc = m > 0.f ? 448.f / m : 1.f;
        unsigned qq[4];
#pragma unroll
        for (int q = 0; q < 4; ++q) {
          int t = 0;
          t = __builtin_amdgcn_cvt_pk_fp8_f32(v[u][q][0] * sc, v[u][q][1] * sc, t, false);
          t = __builtin_amdgcn_cvt_pk_fp8_f32(v[u][q][2] * sc, v[u][q][3] * sc, t, true);
          qq[q] = (unsigned)t;
        }
        *(uint4*)((isv ? p.V8 : p.U8) + (size_t)rr * D + lane * 16) = make_uint4(qq[0], qq[1], qq[2], qq[3]);
        if (lane == 0) (isv ? p.VSC : p.USC)[rr] = m > 0.f ? m * (1.f / 448.f) : 1.f;
      }
    }
  }
}
__device__ __forceinline__ void fp8x16_to_f32(const uint4& q, float* o) {
  f32x2_t t;
  t = __builtin_amdgcn_cvt_pk_f32_fp8((int)q.x, false); o[0] = t[0]; o[1] = t[1];
  t = __builtin_amdgcn_cvt_pk_f32_fp8((int)q.x, true);  o[2] = t[0]; o[3] = t[1];
  t = __builtin_amdgcn_cvt_pk_f32_fp8((int)q.y, false); o[4] = t[0]; o[5] = t[1];
  t = __builtin_amdgcn_cvt_pk_f32_fp8((int)q.y, true);  o[6] = t[0]; o[7] = t[1];
  t = __builtin_amdgcn_cvt_pk_f32_fp8((int)q.z, false); o[8] = t[0]; o[9] = t[1];
  t = __builtin_amdgcn_cvt_pk_f32_fp8((int)q.z, true);  o[10] = t[0]; o[11] = t[1];
  t = __builtin_amdgcn_cvt_pk_f32_fp8((int)q.w, false); o[12] = t[0]; o[13] = t[1];
  t = __builtin_amdgcn_cvt_pk_f32_fp8((int)q.w, true);  o[14] = t[0]; o[15] = t[1];
}
typedef __bf16 bf2v __attribute__((ext_vector_type(2)));
__device__ __forceinline__ float dot16_fp8_bf16(const uint4& q, const uint4& h0, const uint4& h1) {
  float a0 = 0.f, a1 = 0.f;
#define D16STEP(QW, HA, HB)                                                                                   \
  a0 = __builtin_amdgcn_fdot2_f32_bf16(__builtin_amdgcn_cvt_scalef32_pk_bf16_fp8((QW), 1.0f, false), __builtin_bit_cast(bf2v, (HA)), a0, false); \
  a1 = __builtin_amdgcn_fdot2_f32_bf16(__builtin_amdgcn_cvt_scalef32_pk_bf16_fp8((QW), 1.0f, true), __builtin_bit_cast(bf2v, (HB)), a1, false);
  D16STEP(q.x, h0.x, h0.y) D16STEP(q.y, h0.z, h0.w) D16STEP(q.z, h1.x, h1.y) D16STEP(q.w, h1.z, h1.w)
#undef D16STEP
  return a0 + a1;
}
template <int CTRL, int BANKMASK>
__device__ __forceinline__ float dpp_mov_bank(float old, float v) {
  return __int_as_float(__builtin_amdgcn_update_dpp(__float_as_int(old), __float_as_int(v), CTRL, 0xf, BANKMASK, false));
}
__device__ __forceinline__ float reduce8_scatter(const float (&pv)[8], int lane) {
  const bool b0 = lane & 1, b1 = lane & 2, b2 = lane & 4;
  float q[4], r[2];
#pragma unroll
  for (int i = 0; i < 4; ++i) {
    const float keep = b0 ? pv[2 * i + 1] : pv[2 * i], send = b0 ? pv[2 * i] : pv[2 * i + 1];
    q[i] = keep + __int_as_float(__builtin_amdgcn_update_dpp(0, __float_as_int(send), 0xB1, 0xf, 0xf, false));
  }
#pragma unroll
  for (int i = 0; i < 2; ++i) {
    const float keep = b1 ? q[2 * i + 1] : q[2 * i], send = b1 ? q[2 * i] : q[2 * i + 1];
    r[i] = keep + __int_as_float(__builtin_amdgcn_update_dpp(0, __float_as_int(send), 0x4E, 0xf, 0xf, false));
  }
  const float keep = b2 ? r[1] : r[0], send = b2 ? r[0] : r[1];
  float recv = dpp_mov_bank<0x104, 0x5>(send, send);
  recv = dpp_mov_bank<0x114, 0xA>(recv, send);
  float s = keep + recv;
  s += __int_as_float(__builtin_amdgcn_update_dpp(0, __float_as_int(s), 0x128, 0xf, 0xf, false));
  s += __int_as_float(__builtin_amdgcn_ds_bpermute((lane ^ 16) << 2, __float_as_int(s)));
  s += __int_as_float(__builtin_amdgcn_ds_bpermute((lane ^ 32) << 2, __float_as_int(s)));
  return s;
}
__device__ void peer8_phase(const P& p, int l, char* smem, const int g_wbase) {
  const In& in = p.in;
  const int tid_ = otid(g_wbase);
  const int lane = tid_ & 63, w = __builtin_amdgcn_readfirstlane(tid_ >> 6);
  const unsigned char* U8 = p.U8 + (size_t)l * 16384 * D;
  const unsigned char* V8 = p.V8 + (size_t)l * 16384 * D;
  const float* USC = p.USC + (size_t)l * 16384;
  const float* VSC = p.VSC + (size_t)l * 16384;
  const float* mod_l = p.MOD + (size_t)l * NCOND * 6144;
  const float* mod_n = p.MOD + (size_t)(l + 1 < DEPTH ? l + 1 : l) * NCOND * 6144;
  const int tstride = gridDim.x * 4;
  for (int tbase = blockIdx.x * 4 + w; tbase < T; tbase += 16 * tstride) {
  int kk = 0;
  for (int t = tbase; t < T && kk < 16; t += tstride, ++kk) {
    const uint4 ha = *(const uint4*)&p.H2b[(size_t)t * D + lane * 16];
    const uint4 hb = *(const uint4*)&p.H2b[(size_t)t * D + lane * 16 + 8];
    int e_lo, e_hi;
    {
      const int e0 = p.EIDX[(size_t)t * 128 + lane], e1 = p.EIDX[(size_t)t * 128 + 64 + lane];
      const float q0 = p.GATE[(size_t)t * 128 + lane], q1 = p.GATE[(size_t)t * 128 + 64 + lane];
      const int k0 = e0 >> 9, k1 = e1 >> 9;
      int base = 0, pos0 = 0, pos1 = 0;
#pragma unroll 4
      for (int r = 0; r < 32; ++r) {
        const unsigned long long m0 = __ballot(k0 == r), m1 = __ballot(k1 == r);
        const int c0 = __popcll(m0), c1 = __popcll(m1);
        const int lt0 = __builtin_amdgcn_mbcnt_hi((unsigned)(m0 >> 32), __builtin_amdgcn_mbcnt_lo((unsigned)m0, 0u));
        const int lt1 = __builtin_amdgcn_mbcnt_hi((unsigned)(m1 >> 32), __builtin_amdgcn_mbcnt_lo((unsigned)m1, 0u));
        if (k0 == r) pos0 = base + lt0;
        if (k1 == r) pos1 = base + c0 + lt1;
        base += c0 + c1;
      }
      int* SE = (int*)(smem + w * 16384 + kk * 1024);
      float* SG = (float*)(smem + w * 16384 + kk * 1024 + 512);
      __builtin_amdgcn_wave_barrier();
      SE[pos0] = e0; SE[pos1] = e1; SG[pos0] = q0; SG[pos1] = q1;
      __builtin_amdgcn_wave_barrier();
      e_lo = SE[lane]; e_hi = SE[64 + lane];
      __builtin_amdgcn_wave_barrier();
    }
    float a_lo = 0.f, a_hi = 0.f;
    uint4 cb[8], nb[8];
#define P8_LOAD(DST, TAB, B)                                                             \
    {                                                                                    \
      const int src_ = (B) < 8 ? e_lo : e_hi;                                            \
      _Pragma("unroll") for (int k_ = 0; k_ < 8; ++k_) {                                 \
        int ei_ = __builtin_amdgcn_readlane(src_, (((B) & 7) << 3) + k_);                \
        DST[k_] = *((const uint4*)((TAB) + (size_t)ei_ * D) + lane);                     \
      }                                                                                  \
    }
#define P8_UCOMP(SRC, B)                                                                 \
    {                                                                                    \
      float pv_[8];                                                                      \
      _Pragma("unroll") for (int k = 0; k < 8; ++k) pv_[k] = dot16_fp8_bf16(SRC[k], ha, hb); \
      const float s_ = reduce8_scatter(pv_, lane);       \
      if ((B) < 8) a_lo = ((lane >> 3) == ((B) & 7)) ? s_ : a_lo; else a_hi = ((lane >> 3) == ((B) & 7)) ? s_ : a_hi; \
    }
    P8_LOAD(cb, U8, 0)
    for (int b = 0; b < 16; b += 2) {
      P8_LOAD(nb, U8, b + 1)
      __builtin_amdgcn_sched_barrier(0);
      P8_UCOMP(cb, b)
      __builtin_amdgcn_sched_barrier(0);
      if (b + 2 < 16) P8_LOAD(cb, U8, b + 2)
      __builtin_amdgcn_sched_barrier(0);
      P8_UCOMP(nb, b + 1)
      __builtin_amdgcn_sched_barrier(0);
    }
    {
      float* SG = (float*)(smem + w * 16384 + kk * 1024 + 512);
      const float w_lo = SG[lane] * gelu_f(a_lo * USC[e_lo]) * VSC[e_lo], w_hi = SG[64 + lane] * gelu_f(a_hi * USC[e_hi]) * VSC[e_hi];
      SG[lane] = w_lo; SG[64 + lane] = w_hi;
    }
  }
  __builtin_amdgcn_wave_barrier();
  kk = 0;
  for (int t = tbase; t < T && kk < 16; t += tstride, ++kk) {
    const int e_lo = ((const int*)(smem + w * 16384 + kk * 1024))[lane], e_hi = ((const int*)(smem + w * 16384 + kk * 1024))[64 + lane];
    const float w_lo = ((const float*)(smem + w * 16384 + kk * 1024 + 512))[lane], w_hi = ((const float*)(smem + w * 16384 + kk * 1024 + 512))[64 + lane];
    uint4 cb[8], nb[8];
    float f[16];
#pragma unroll
    for (int i = 0; i < 16; ++i) f[i] = 0.f;
#define P8_VCOMP(SRC, B)                                                                 \
    {                                                                                    \
      const float wsrc = (B) < 8 ? w_lo : w_hi;                                          \
      _Pragma("unroll") for (int k = 0; k < 8; ++k) {                                    \
        const float we = __int_as_float(__builtin_amdgcn_readlane(__float_as_int(wsrc), (((B) & 7) << 3) + k)); \
        float v[16];                                                                     \
        fp8x16_to_f32(SRC[k], v);                                                        \
        _Pragma("unroll") for (int i = 0; i < 16; ++i) f[i] += we * v[i];                \
      }                                                                                  \
    }
    P8_LOAD(cb, V8, 0)
    for (int b = 0; b < 16; b += 2) {
      P8_LOAD(nb, V8, b + 1)
      __builtin_amdgcn_sched_barrier(0);
      P8_VCOMP(cb, b)
      __builtin_amdgcn_sched_barrier(0);
      if (b + 2 < 16) P8_LOAD(cb, V8, b + 2)
      __builtin_amdgcn_sched_barrier(0);
      P8_VCOMP(nb, b + 1)
      __builtin_amdgcn_sched_barrier(0);
    }
    const float* m = mod_l + (size_t)cond_of(t) * 6144;
    const float* mn = mod_n + (size_t)cond_of(t) * 6144;
    const int d0 = lane * 16;
    float v[16];
    float s = 0.f;
#pragma unroll
    for (int q = 0; q < 4; ++q) {
      float4 xa = *(const float4*)&p.X1[(size_t)t * D + d0 + q * 4];
      float4 ga = *(const float4*)&m[5120 + d0 + q * 4];
      v[q * 4 + 0] = ALPHA * xa.x + ga.x * f[q * 4 + 0]; v[q * 4 + 1] = ALPHA * xa.y + ga.y * f[q * 4 + 1];
      v[q * 4 + 2] = ALPHA * xa.z + ga.z * f[q * 4 + 2]; v[q * 4 + 3] = ALPHA * xa.w + ga.w * f[q * 4 + 3];
    }
#pragma unroll
    for (int i = 0; i < 16; ++i) s += v[i];
    const float mu = wave_sum_u(s) * (1.f / 1024.f);
    float sq = 0.f;
#pragma unroll
    for (int i = 0; i < 16; ++i) { v[i] -= mu; sq += v[i] * v[i]; }
    const float r = rsqrtf(wave_sum_u(sq) * (1.f / 1024.f) + LN_EPS);
    float o[16];
#pragma unroll
    for (int q = 0; q < 4; ++q) {
      float4 gg = *(const float4*)&in.ln2_g[l * D + d0 + q * 4], bb = *(const float4*)&in.ln2_b[l * D + d0 + q * 4];
      o[q * 4 + 0] = v[q * 4 + 0] * r * gg.x + bb.x; o[q * 4 + 1] = v[q * 4 + 1] * r * gg.y + bb.y;
      o[q * 4 + 2] = v[q * 4 + 2] * r * gg.z + bb.z; o[q * 4 + 3] = v[q * 4 + 3] * r * gg.w + bb.w;
      *(float4*)&p.X[(size_t)t * D + d0 + q * 4] = make_float4(o[q * 4], o[q * 4 + 1], o[q * 4 + 2], o[q * 4 + 3]);
    }
    if (l == DEPTH - 1) {
#pragma unroll
      for (int q = 0; q < 4; ++q) *(float4*)&p.out[(size_t)t * D + d0 + q * 4] = make_float4(o[q * 4], o[q * 4 + 1], o[q * 4 + 2], o[q * 4 + 3]);
    } else {
      unsigned hq[8];
#pragma unroll
      for (int q = 0; q < 8; ++q) {
        const int d = d0 + q * 2;
        hq[q] = pack2bf(o[q * 2] * (1.f + mn[1024 + d]) + mn[d], o[q * 2 + 1] * (1.f + mn[1024 + d + 1]) + mn[d + 1]);
      }
      *(uint4*)&p.Hb[(size_t)t * D + d0] = make_uint4(hq[0], hq[1], hq[2], hq[3]);
      *(uint4*)&p.Hb[(size_t)t * D + d0 + 8] = make_uint4(hq[4], hq[5], hq[6], hq[7]);
    }
  }
  __builtin_amdgcn_wave_barrier();
  }
}

template <int UG, int VG>
__device__ void peerx_phase(const P& p, int l, char* smem, const int g_wbase) {
  const In& in = p.in;
  const int tid_ = otid(g_wbase);
  const int lane = tid_ & 63, w = __builtin_amdgcn_readfirstlane(tid_ >> 6);
  const unsigned char* U8 = p.U8 + (size_t)l * 16384 * D;
  const unsigned char* V8 = p.V8 + (size_t)l * 16384 * D;
  const __amdgpu_buffer_rsrc_t U8r = __builtin_amdgcn_make_buffer_rsrc((void*)U8, 0, 16384 * D, 0x00020000);
  const __amdgpu_buffer_rsrc_t V8r = __builtin_amdgcn_make_buffer_rsrc((void*)V8, 0, 16384 * D, 0x00020000);
  const float* USC = p.USC + (size_t)l * 16384;
  const float* VSC = p.VSC + (size_t)l * 16384;
  const float* mod_l = p.MOD + (size_t)l * NCOND * 6144;
  const float* mod_n = p.MOD + (size_t)(l + 1 < DEPTH ? l + 1 : l) * NCOND * 6144;
  const int tstride = gridDim.x * 4;
  char* SW = smem + w * 16384;
  for (int tbase = blockIdx.x * 4 + w; tbase < T; tbase += 16 * tstride) {
    int ntok = (T - tbase + tstride - 1) / tstride;
    ntok = ntok > 16 ? 16 : ntok;
    const bool staged = ntok <= 8;
    if (staged) {
      int e0a[8], e1a[8];
      float q0a[8], q1a[8];
#pragma unroll
      for (int j = 0; j < 8; ++j) {
        const int kc = j < ntok ? j : ntok - 1;
        const int t = __builtin_amdgcn_readfirstlane(tbase + kc * tstride);
        e0a[j] = p.EIDX[(size_t)t * 128 + lane]; e1a[j] = p.EIDX[(size_t)t * 128 + 64 + lane];
        q0a[j] = p.GATE[(size_t)t * 128 + lane]; q1a[j] = p.GATE[(size_t)t * 128 + 64 + lane];
      }
#pragma unroll
      for (int j = 0; j < 8; ++j) {
        int* ST = (int*)(SW + 8192 + j * 1024);
        ST[lane] = e0a[j]; ST[64 + lane] = e1a[j]; ST[128 + lane] = __float_as_int(q0a[j]); ST[192 + lane] = __float_as_int(q1a[j]);
      }
      __builtin_amdgcn_wave_barrier();
    }
    for (int kk = 0; kk < ntok; ++kk) {
      int e0, e1;
      float q0, q1;
      if (staged) {
        const int* ST = (const int*)(SW + 8192 + kk * 1024);
        e0 = ST[lane]; e1 = ST[64 + lane]; q0 = __int_as_float(ST[128 + lane]); q1 = __int_as_float(ST[192 + lane]);
      } else {
        const int t = __builtin_amdgcn_readfirstlane(tbase + kk * tstride);
        e0 = p.EIDX[(size_t)t * 128 + lane]; e1 = p.EIDX[(size_t)t * 128 + 64 + lane];
        q0 = p.GATE[(size_t)t * 128 + lane]; q1 = p.GATE[(size_t)t * 128 + 64 + lane];
      }
      const int k0 = e0 >> 9, k1 = e1 >> 9;
      int base = 0, pos0 = 0, pos1 = 0;
#pragma unroll 4
      for (int r = 0; r < 32; ++r) {
        const unsigned long long m0 = __ballot(k0 == r), m1 = __ballot(k1 == r);
        const int c0 = __popcll(m0), c1 = __popcll(m1);
        const int lt0 = __builtin_amdgcn_mbcnt_hi((unsigned)(m0 >> 32), __builtin_amdgcn_mbcnt_lo((unsigned)m0, 0u));
        const int lt1 = __builtin_amdgcn_mbcnt_hi((unsigned)(m1 >> 32), __builtin_amdgcn_mbcnt_lo((unsigned)m1, 0u));
        if (k0 == r) pos0 = base + lt0;
        if (k1 == r) pos1 = base + c0 + lt1;
        base += c0 + c1;
      }
      int* SE = (int*)(SW + kk * 1024);
      float* SG = (float*)(SW + kk * 1024 + 512);
      SE[pos0] = e0; SE[pos1] = e1; SG[pos0] = q0; SG[pos1] = q1;
    }
    __builtin_amdgcn_wave_barrier();
    uint4 cb[8], nb[8];
#define PX_LOAD(DST, TAB, KK, B)                                                         \
    {                                                                                    \
      const int4 ea_ = *(const int4*)(SW + (KK) * 1024 + (B) * 32);                      \
      const int4 eb_ = *(const int4*)(SW + (KK) * 1024 + (B) * 32 + 16);                 \
      const int ei_[8] = {ea_.x, ea_.y, ea_.z, ea_.w, eb_.x, eb_.y, eb_.z, eb_.w};       \
      _Pragma("unroll") for (int k_ = 0; k_ < 8; ++k_)                                   \
        DST[k_] = __builtin_bit_cast(uint4, __builtin_amdgcn_raw_buffer_load_b128(TAB##r, lane * 16, __builtin_amdgcn_readfirstlane(ei_[k_]) * D, 0)); \
    }
    for (int g0 = 0; g0 < ntok; g0 += UG) {
      uint4 hq[UG];
      float hsc[UG];
      float alo[UG], ahi[UG];
      int kidx[UG];
      const bool dg_valid = (lane >> 4) == ((lane & 15) >> 2);
      const int dg_r = lane & 3;
#pragma unroll
      for (int i = 0; i < UG; ++i) {
        kidx[i] = (g0 + i < ntok) ? g0 + i : ntok - 1;
        const int t = __builtin_amdgcn_readfirstlane(tbase + kidx[i] * tstride);
        float hv[16];
        ld16b(p.H2b + (size_t)t * D + lane * 16, hv);
        float mxv = 0.f;
#pragma unroll
        for (int q = 0; q < 16; ++q) mxv = fmaxf(mxv, fabsf(hv[q]));
        mxv = wave_max_u(mxv);
        const float qs = mxv > 0.f ? 448.f / mxv : 1.f;
        hsc[i] = mxv > 0.f ? mxv * (1.f / 448.f) : 1.f;
        unsigned qq[4];
#pragma unroll
        for (int q = 0; q < 4; ++q) {
          int tt = 0;
          tt = __builtin_amdgcn_cvt_pk_fp8_f32(hv[q * 4 + 0] * qs, hv[q * 4 + 1] * qs, tt, false);
          tt = __builtin_amdgcn_cvt_pk_fp8_f32(hv[q * 4 + 2] * qs, hv[q * 4 + 3] * qs, tt, true);
          qq[q] = (unsigned)tt;
        }
        hq[i] = make_uint4(qq[0], qq[1], qq[2], qq[3]);
        alo[i] = 0.f; ahi[i] = 0.f;
      }
#define PX_PK64(LO, HI) ((long)(((unsigned long long)(HI) << 32) | (unsigned long long)(LO)))
#define PX_UCOMP(SRC, I, B)                                                              \
      {                                                                                  \
        float pv_[8];                                                                    \
        _Pragma("unroll") for (int k = 0; k < 8; ++k) {                                  \
          f32x4 d_ = __builtin_amdgcn_mfma_f32_16x16x32_fp8_fp8(PX_PK64(SRC[k].x, SRC[k].y), PX_PK64(hq[I].x, hq[I].y), (f32x4{0.f, 0.f, 0.f, 0.f}), 0, 0, 0); \
          d_ = __builtin_amdgcn_mfma_f32_16x16x32_fp8_fp8(PX_PK64(SRC[k].z, SRC[k].w), PX_PK64(hq[I].z, hq[I].w), d_, 0, 0, 0); \
          const float e_ = dg_r == 0 ? d_[0] : (dg_r == 1 ? d_[1] : (dg_r == 2 ? d_[2] : d_[3])); \
          pv_[k] = dg_valid ? e_ : 0.f;                                                  \
        }                                                                                \
        const float s_ = reduce8_scatter(pv_, lane);                                     \
        if ((B) < 8) alo[I] = ((lane >> 3) == ((B) & 7)) ? s_ : alo[I]; else ahi[I] = ((lane >> 3) == ((B) & 7)) ? s_ : ahi[I]; \
      }
      PX_LOAD(cb, U8, kidx[0], 0)
      for (int b = 0; b < 16; ++b) {
#pragma unroll
        for (int i = 0; i < UG; i += 2) {
          PX_LOAD(nb, U8, kidx[i + 1], b)
          PX_UCOMP(cb, i, b)
          if (i + 2 < UG) { PX_LOAD(cb, U8, kidx[i + 2], b) } else if (b + 1 < 16) { PX_LOAD(cb, U8, kidx[0], b + 1) }
          PX_UCOMP(nb, i + 1, b)
        }
      }
#pragma unroll
      for (int i = 0; i < UG; ++i) {
        const int* SE = (const int*)(SW + kidx[i] * 1024);
        float* SG = (float*)(SW + kidx[i] * 1024 + 512);
        const int e_lo = SE[lane], e_hi = SE[64 + lane];
        const float w_lo = SG[lane] * gelu_f(alo[i] * (USC[e_lo] * hsc[i])) * VSC[e_lo], w_hi = SG[64 + lane] * gelu_f(ahi[i] * (USC[e_hi] * hsc[i])) * VSC[e_hi];
        __builtin_amdgcn_wave_barrier();
        if (g0 + i < ntok) { SG[lane] = w_lo; SG[64 + lane] = w_hi; }
        __builtin_amdgcn_wave_barrier();
      }
    }
    for (int g0 = 0; g0 < ntok; g0 += VG) {
      float f[VG][16];
      int kidx[VG];
#pragma unroll
      for (int i = 0; i < VG; ++i) {
        kidx[i] = (g0 + i < ntok) ? g0 + i : ntok - 1;
#pragma unroll
        for (int q = 0; q < 16; ++q) f[i][q] = 0.f;
      }
      uint4 vc[4], vn[4];
#define PX_LOAD4(DST, KK, B)                                                             \
      {                                                                                  \
        const int4 ea_ = *(const int4*)(SW + (KK) * 1024 + (B) * 16);                    \
        const int ei_[4] = {ea_.x, ea_.y, ea_.z, ea_.w};                                 \
        _Pragma("unroll") for (int k_ = 0; k_ < 4; ++k_)                                 \
          DST[k_] = __builtin_bit_cast(uint4, __builtin_amdgcn_raw_buffer_load_b128(V8r, lane * 16, __builtin_amdgcn_readfirstlane(ei_[k_]) * D, 0)); \
      }
#define PX_VCOMP4(SRC, I, B)                                                             \
      {                                                                                  \
        const float4 wa_ = *(const float4*)(SW + kidx[I] * 1024 + 512 + (B) * 16);       \
        const float ww_[4] = {wa_.x, wa_.y, wa_.z, wa_.w};                               \
        _Pragma("unroll") for (int k = 0; k < 4; ++k) {                                  \
          const float we = __int_as_float(__builtin_amdgcn_readfirstlane(__float_as_int(ww_[k]))); \
          float v[16];                                                                   \
          fp8x16_to_f32(SRC[k], v);                                                      \
          _Pragma("unroll") for (int q = 0; q < 16; ++q) f[I][q] += we * v[q];           \
        }                                                                                \
      }
      PX_LOAD4(vc, kidx[0], 0)
      for (int b = 0; b < 32; ++b) {
#pragma unroll
        for (int i = 0; i < VG; i += 2) {
          PX_LOAD4(vn, kidx[i + 1], b)
          PX_VCOMP4(vc, i, b)
          if (i + 2 < VG) { PX_LOAD4(vc, kidx[i + 2], b) } else if (b + 1 < 32) { PX_LOAD4(vc, kidx[0], b + 1) }
          PX_VCOMP4(vn, i + 1, b)
        }
      }
#pragma unroll
      for (int i = 0; i < VG; ++i) {
        if (g0 + i < ntok) {
          const int t = __builtin_amdgcn_readfirstlane(tbase + kidx[i] * tstride);
          const float* m = mod_l + (size_t)cond_of(t) * 6144;
          const float* mn = mod_n + (size_t)cond_of(t) * 6144;
          int ln_ = lane;
          asm volatile("" : "+v"(ln_));
          const int d0 = ln_ * 16;
          float4 nsc[4], nsh[4];
          if (l < DEPTH - 1) {
#pragma unroll
            for (int q = 0; q < 4; ++q) { nsc[q] = *(const float4*)&mn[1024 + d0 + q * 4]; nsh[q] = *(const float4*)&mn[d0 + q * 4]; }
          }
          float v[16];
          float s = 0.f;
          {
            float mx16[16];
            ld16b(p.MIXb + (size_t)t * D + d0, mx16);
            const float mu1 = p.LN1S[2 * t], r1 = p.LN1S[2 * t + 1];
#pragma unroll
            for (int q = 0; q < 4; ++q) {
              const float4 g1 = *(const float4*)&in.ln1_g[l * D + d0 + q * 4], b1 = *(const float4*)&in.ln1_b[l * D + d0 + q * 4];
              const float4 ga = *(const float4*)&m[5120 + d0 + q * 4];
              v[q * 4 + 0] = ALPHA * ((mx16[q * 4 + 0] - mu1) * r1 * g1.x + b1.x) + ga.x * f[i][q * 4 + 0];
              v[q * 4 + 1] = ALPHA * ((mx16[q * 4 + 1] - mu1) * r1 * g1.y + b1.y) + ga.y * f[i][q * 4 + 1];
              v[q * 4 + 2] = ALPHA * ((mx16[q * 4 + 2] - mu1) * r1 * g1.z + b1.z) + ga.z * f[i][q * 4 + 2];
              v[q * 4 + 3] = ALPHA * ((mx16[q * 4 + 3] - mu1) * r1 * g1.w + b1.w) + ga.w * f[i][q * 4 + 3];
            }
          }
#pragma unroll
          for (int q = 0; q < 16; ++q) s += v[q];
          const float mu = wave_sum_u(s) * (1.f / 1024.f);
          float sq = 0.f;
#pragma unroll
          for (int q = 0; q < 16; ++q) { v[q] -= mu; sq += v[q] * v[q]; }
          const float r = rsqrtf(wave_sum_u(sq) * (1.f / 1024.f) + LN_EPS);
          float o[16];
#pragma unroll
          for (int q = 0; q < 4; ++q) {
            float4 gg = *(const float4*)&in.ln2_g[l * D + d0 + q * 4], bb = *(const float4*)&in.ln2_b[l * D + d0 + q * 4];
            o[q * 4 + 0] = v[q * 4 + 0] * r * gg.x + bb.x; o[q * 4 + 1] = v[q * 4 + 1] * r * gg.y + bb.y;
            o[q * 4 + 2] = v[q * 4 + 2] * r * gg.z + bb.z; o[q * 4 + 3] = v[q * 4 + 3] * r * gg.w + bb.w;
          }
          if (l < DEPTH - 1) {
            *(uint4*)&p.Xb[(size_t)t * D + d0] = make_uint4(pack2bf(o[0], o[1]), pack2bf(o[2], o[3]), pack2bf(o[4], o[5]), pack2bf(o[6], o[7]));
            *(uint4*)&p.Xb[(size_t)t * D + d0 + 8] = make_uint4(pack2bf(o[8], o[9]), pack2bf(o[10], o[11]), pack2bf(o[12], o[13]), pack2bf(o[14], o[15]));
          }
          if (l == DEPTH - 1) {
#pragma unroll
            for (int q = 0; q < 4; ++q) *(float4*)&p.out[(size_t)t * D + d0 + q * 4] = make_float4(o[q * 4], o[q * 4 + 1], o[q * 4 + 2], o[q * 4 + 3]);
          } else {
            unsigned hq[8];
#pragma unroll
            for (int q = 0; q < 4; ++q) {
              hq[2 * q] = pack2bf(o[q * 4] * (1.f + nsc[q].x) + nsh[q].x, o[q * 4 + 1] * (1.f + nsc[q].y) + nsh[q].y);
              hq[2 * q + 1] = pack2bf(o[q * 4 + 2] * (1.f + nsc[q].z) + nsh[q].z, o[q * 4 + 3] * (1.f + nsc[q].w) + nsh[q].w);
            }
            *(uint4*)&p.Hb[(size_t)t * D + d0] = make_uint4(hq[0], hq[1], hq[2], hq[3]);
            *(uint4*)&p.Hb[(size_t)t * D + d0 + 8] = make_uint4(hq[4], hq[5], hq[6], hq[7]);
          }
        }
      }
    }
    __builtin_amdgcn_wave_barrier();
  }
}

__device__ void ln1_phase(const P& p, int l, char* smem, const int g_wbase) {
  const In& in = p.in;
  const int tid = otid(g_wbase), lane = tid & 63, w = tid >> 6;
  const float* mod_l = p.MOD + (size_t)l * NCOND * 6144;
  for (int t = blockIdx.x * 4 + w; t < T; t += gridDim.x * 4) {
    const float* m = mod_l + (size_t)cond_of(t) * 6144;
    const int d0 = lane * 16;
    float v[16];
    float s = 0.f;
    ld16b(p.MIXb + (size_t)t * D + d0, v);
#pragma unroll
    for (int q = 0; q < 16; ++q) s += v[q];
    const float mu = wave_sum_u(s) * (1.f / 1024.f);
    float sq = 0.f;
#pragma unroll
    for (int i = 0; i < 16; ++i) { v[i] -= mu; sq += v[i] * v[i]; }
    const float r = rsqrtf(wave_sum_u(sq) * (1.f / 1024.f) + LN_EPS);
    unsigned hq[8];
#pragma unroll
    for (int q = 0; q < 4; ++q) {
      float4 gg = *(const float4*)&in.ln1_g[l * D + d0 + q * 4], bb = *(const float4*)&in.ln1_b[l * D + d0 + q * 4];
      float4 sc = *(const float4*)&m[4096 + d0 + q * 4], sh = *(const float4*)&m[3072 + d0 + q * 4];
      float x0 = v[q * 4] * r * gg.x + bb.x, x1 = v[q * 4 + 1] * r * gg.y + bb.y, x2 = v[q * 4 + 2] * r * gg.z + bb.z, x3 = v[q * 4 + 3] * r * gg.w + bb.w;
      hq[q * 2] = pack2bf(x0 * (1.f + sc.x) + sh.x, x1 * (1.f + sc.y) + sh.y);
      hq[q * 2 + 1] = pack2bf(x2 * (1.f + sc.z) + sh.z, x3 * (1.f + sc.w) + sh.w);
    }
    *(uint4*)&p.H2b[(size_t)t * D + d0] = make_uint4(hq[0], hq[1], hq[2], hq[3]);
    *(uint4*)&p.H2b[(size_t)t * D + d0 + 8] = make_uint4(hq[4], hq[5], hq[6], hq[7]);
    if (lane == 0) { p.LN1S[2 * t] = mu; p.LN1S[2 * t + 1] = r; }
  }
}


__device__ void tabconv_share(const P& p, int l, const int g_wbase) {
  const In& in = p.in;
  const int tid = otid(g_wbase), lane = tid & 63, w = tid >> 6;
  const int nrow_blk = (32768 + (int)gridDim.x - 1) / (int)gridDim.x;
  const int r_begin = blockIdx.x * nrow_blk, r_end = min(32768, r_begin + nrow_blk);
  for (int r0 = r_begin + w * 2; r0 < r_end; r0 += 8) {
    f32x4 cv[2][4];
#pragma unroll
    for (int u = 0; u < 2; ++u) {
      const int cr = r0 + u;
      if (cr < r_end) {
        const float* s = (cr < 16384 ? in.peer_u + ((size_t)l * 16384 + cr) * D : in.peer_v + ((size_t)l * 16384 + (cr - 16384)) * D) + lane * 16;
#pragma unroll
        for (int q = 0; q < 4; ++q) cv[u][q] = __builtin_nontemporal_load((const f32x4*)s + q);
      }
    }
#pragma unroll
    for (int u = 0; u < 2; ++u) {
      const int cr = r0 + u;
      if (cr < r_end) {
        const bool isv = cr >= 16384;
        const int rr = l * 16384 + (isv ? cr - 16384 : cr);
        float mx = 0.f;
#pragma unroll
        for (int q = 0; q < 4; ++q)
#pragma unroll
          for (int i = 0; i < 4; ++i) mx = fmaxf(mx, fabsf(cv[u][q][i]));
        mx = wave_max_u(mx);
        const float sc = mx > 0.f ? 448.f / mx : 1.f;
        unsigned qq[4];
#pragma unroll
        for (int q = 0; q < 4; ++q) {
          int tt = 0;
          tt = __builtin_amdgcn_cvt_pk_fp8_f32(cv[u][q][0] * sc, cv[u][q][1] * sc, tt, false);
          tt = __builtin_amdgcn_cvt_pk_fp8_f32(cv[u][q][2] * sc, cv[u][q][3] * sc, tt, true);
          qq[q] = (unsigned)tt;
        }
        *(uint4*)((isv ? p.V8 : p.U8) + (size_t)rr * D + lane * 16) = make_uint4(qq[0], qq[1], qq[2], qq[3]);
        if (lane == 0) (isv ? p.VSC : p.USC)[rr] = mx > 0.f ? mx * (1.f / 448.f) : 1.f;
      }
    }
  }
}

#define XB_TMO      128
#define XB_XCNT(j)  (256  + 64 * (j))
#define XB_XSUB(j)  (1280 + 64 * (j))
#define XB_XGEN(j)  (2304 + 64 * (j))
#define XB_TOP      3328
#define XB_TOPGEN   3392
#define XCD_BAR_WORDS 3456
#define XB_SPIN_CAP (1u << 22)
#define LAS __attribute__((address_space(3)))
__device__ __forceinline__ unsigned xb_ld(unsigned* q)              { return __hip_atomic_load(q, __ATOMIC_RELAXED, __HIP_MEMORY_SCOPE_AGENT); }
__device__ __forceinline__ unsigned xb_add(unsigned* q, unsigned v) { return __hip_atomic_fetch_add(q, v, __ATOMIC_RELAXED, __HIP_MEMORY_SCOPE_AGENT); }
__device__ __forceinline__ unsigned xb_xcc_id() { return (unsigned)__builtin_amdgcn_s_getreg((3 << 11) | 20) & 0xFu; }
#define XB_SPIN(cond, bar) do { unsigned _sp = 0; while (cond) { __builtin_amdgcn_s_sleep(1); \
    if ((++_sp & 255u) == 0u) { if (xb_ld(&(bar)[XB_TMO])) break; if (_sp > XB_SPIN_CAP) { atomicAdd(&(bar)[XB_TMO], 1u); break; } } } } while (0)
struct XcdBarrier { unsigned* bar; unsigned x; volatile LAS unsigned* st; };
__device__ __forceinline__ XcdBarrier xcd_barrier_post(unsigned* bar, volatile LAS unsigned* st) {
  XcdBarrier b; b.bar = bar; b.x = xb_xcc_id(); b.st = st;
  if (threadIdx.x == 0) (void)xb_add(&bar[XB_XCNT(b.x)], 1u);
  return b;
}
__device__ __forceinline__ void xcd_barrier_complete(unsigned* bar, unsigned x, unsigned& nloc, unsigned& nx) {
  const unsigned G = gridDim.x * gridDim.y * gridDim.z;
  unsigned sum, cnt, mine, sp = 0u;
  for (;;) {
    sum = 0u; cnt = 0u; mine = 0u;
#pragma unroll
    for (unsigned j = 0; j < 16; ++j) { const unsigned c = xb_ld(&bar[XB_XCNT(j)]); sum += c; cnt += (c > 0u) ? 1u : 0u; mine = (j == x) ? c : mine; }
    if (sum == G) break;
    __builtin_amdgcn_s_sleep(1);
    if ((++sp & 255u) == 0u) { if (xb_ld(&bar[XB_TMO])) break; if (sp > XB_SPIN_CAP) { atomicAdd(&bar[XB_TMO], 1u); break; } }
  }
  nloc = mine > 0u ? mine : 1u; nx = cnt > 0u ? cnt : 1u;
}
__device__ __forceinline__ void xcd_barrier(const XcdBarrier& b) {
  asm volatile("s_waitcnt vmcnt(0)" ::: "memory");
  __syncthreads();
  if (threadIdx.x == 0) {
    unsigned* bar = b.bar;
    unsigned bx = b.x;
    asm volatile("" : "+v"(bx));
    __builtin_amdgcn_s_waitcnt(0);
    unsigned nloc = b.st[0], nx = b.st[1];
    if (nloc == 0u) { xcd_barrier_complete(bar, bx, nloc, nx); b.st[0] = nloc; b.st[1] = nx; }
    const unsigned old = xb_add(&bar[XB_XSUB(bx)], 1u);
    const unsigned gen = old / nloc;
    if (old + 1u == (gen + 1u) * nloc) {
      __builtin_amdgcn_fence(__ATOMIC_RELEASE, "agent");
      asm volatile("s_waitcnt vmcnt(0)" ::: "memory");
      const unsigned og = xb_add(&bar[XB_TOP], 1u);
      const unsigned tg = og / nx;
      if (og + 1u == (tg + 1u) * nx) xb_add(&bar[XB_TOPGEN], 1u);
      else XB_SPIN(xb_ld(&bar[XB_TOPGEN]) == tg, bar);
      __builtin_amdgcn_fence(__ATOMIC_ACQUIRE, "agent");
      xb_add(&bar[XB_XGEN(bx)], 1u);
      asm volatile("s_waitcnt vmcnt(0)" ::: "memory");
    } else {
      XB_SPIN(xb_ld(&bar[XB_XGEN(bx)]) == gen, bar);
      __builtin_amdgcn_fence(__ATOMIC_ACQUIRE, "agent");
      asm volatile("s_waitcnt vmcnt(0)" ::: "memory");
    }
  }
  __syncthreads();
}

constexpr int SMEM_BYTES = 65536 + 4096;
__global__ void __launch_bounds__(256, 2) fwd_megakernel(P p) {
  cg::grid_group grid = cg::this_grid();
  const int g_wbase = __builtin_amdgcn_readfirstlane((int)threadIdx.x & ~63);
  __shared__ __attribute__((aligned(16))) char smem[SMEM_BYTES];
  __shared__ uint4 xb_words;
  if (threadIdx.x == 0) xb_words = make_uint4(0u, 0u, 0u, 0u);
  __syncthreads();
  XcdBarrier xb = xcd_barrier_post(p.BAR, (volatile LAS unsigned*)&xb_words);
  mod_fast_phase(p, smem, g_wbase);
  rope_table_phase(p);
  wtrans_phase(p, smem, g_wbase);
  keysconv_phase(p);
  cacheconv_phase(p);
  if (p.use_cg_sync) grid.sync();
  xcd_barrier(xb);
  modulate_phase(p, 0);
  xcd_barrier(xb);
  for (int l = 0; l < DEPTH; ++l) {
    gemm_phase<0>(p, l, p.Hb, p.WinT + (size_t)l * INW * D, nullptr, p.Z, INW, smem, g_wbase);
    xcd_barrier(xb);
    attn_phase(p, l, smem, g_wbase);
    ret_phase(p, l, smem, g_wbase);
    gmlp_phase(p, l, smem, g_wbase);
    conv_fast_phase(p, l, smem, g_wbase);
    ret_state_phase(p, l, smem, g_wbase);
    xcd_barrier(xb);
    gemm_phase<1>(p, l, p.MIXCATb, p.WoutT + (size_t)l * D * D, nullptr, nullptr, D, smem, g_wbase);
    xcd_barrier(xb);
    ln1_phase(p, l, smem, g_wbase);
    xcd_barrier(xb);
    const bool conv_first = (blockIdx.x * 2 >= gridDim.x);
    if (conv_first) tabconv_share(p, l, g_wbase);
    gemm_phase<2>(p, l, p.H2b, p.WqT + (size_t)l * D * D, nullptr, p.Qb, D, smem, g_wbase);
    if (!conv_first) tabconv_share(p, l, g_wbase);
    xcd_barrier(xb);
    peerx_phase<8, 4>(p, l, smem, g_wbase);
    xcd_barrier(xb);
  }
}

extern "C" void kernel_launch(void* const* d_in, const int* in_sizes, int n_in, void* d_out, int out_size,
                              void* d_ws, size_t ws_size, hipStream_t stream) {
  static int grid_blocks = 0;
  if (!grid_blocks) {
    int dev = 0, cus = 0, per_cu = 0;
    (void)hipGetDevice(&dev);
    (void)hipDeviceGetAttribute(&cus, hipDeviceAttributeMultiprocessorCount, dev);
    (void)hipOccupancyMaxActiveBlocksPerMultiprocessor(&per_cu, fwd_megakernel, 256, 0);
    if (per_cu > 2) per_cu = 2;
    if (per_cu < 1) per_cu = 1;
    grid_blocks = cus * per_cu;
  }
  P p{};
  const float** ip = (const float**)&p.in;
  for (int i = 0; i < 30; ++i) ip[i] = (const float*)d_in[i];
  p.out = (float*)d_out;
  float* ws = (float*)d_ws;
  size_t off = 0;
  auto take = [&](size_t n) { float* q = ws + off; off += (n + 63) & ~(size_t)63; return q; };
  p.BAR = (unsigned*)take(XCD_BAR_WORDS);
  (void)hipMemsetAsync(p.BAR, 0, XCD_BAR_WORDS * sizeof(unsigned), stream);
  p.MOD = take((size_t)DEPTH * NCOND * 6144);
  p.ROPE = (float2*)take(1024);
  p.X = take((size_t)T * D);
  p.Hb = (bf16_t*)take((size_t)T * D / 2);
  p.Z = (bf16_t*)take((size_t)T * INW / 2);
  p.MIXCATb = (bf16_t*)take((size_t)T * D / 2);
  p.H2b = (bf16_t*)take((size_t)T * D / 2);
  p.WinT = (bf16_t*)take((size_t)DEPTH * INW * D / 2);
  p.WoutT = (bf16_t*)take((size_t)DEPTH * D * D / 2);
  p.WqT = (bf16_t*)take((size_t)DEPTH * D * D / 2);
  p.U8 = (unsigned char*)take((size_t)DEPTH * 16384 * D / 4);
  p.V8 = (unsigned char*)take((size_t)DEPTH * 16384 * D / 4);
  p.USC = take((size_t)DEPTH * 16384);
  p.VSC = take((size_t)DEPTH * 16384);
  p.Qb = (bf16_t*)take((size_t)T * D / 2);
  p.KEYSb = (bf16_t*)take((size_t)DEPTH * 2 * 128 * 64 / 2);
  p.CKb = (bf16_t*)take((size_t)8 * DEPTH * 512 * 256 / 2);
  p.CVb = (bf16_t*)take((size_t)8 * DEPTH * 512 * 256 / 2);
  p.MIX = take((size_t)T * D);
  p.X1 = take((size_t)T * D);
  p.LN1S = take((size_t)T * 2);
  p.MIXb = (bf16_t*)take((size_t)T * D / 2);
  p.Xb = (bf16_t*)take((size_t)T * D / 2);
  p.EIDX = (int*)take((size_t)T * 128);
  p.GATE = take((size_t)T * 128);
  void* args[] = {&p};
  hipError_t e = hipLaunchCooperativeKernel((void*)fwd_megakernel, dim3(grid_blocks), dim3(256), args, 0, stream);
  if (e != hipSuccess) fprintf(stderr, "cooperative launch failed: %s (grid %d)\n", hipGetErrorString(e), grid_blocks);
}
```
